# Optimizing an MI355X kernel written in HIP

```python
import jax, jax.numpy as jnp
from jax import lax
import numpy as np

D_MODEL = 1024
BATCH = 16
SEQ = 2048
DEPTH = 4

N_MIXERS = 2
N_A = (DEPTH + 1) // 2
N_B = DEPTH // 2
EPS = 1e-6

M_HEADS = 8
M_DV = D_MODEL // M_HEADS
M_DK = M_DV // 2
M_CHUNK = 128
GATE_CAP = 15.0
A_IN = 2 * M_HEADS * M_DK + 2 * D_MODEL + 2 * M_HEADS

G_CHUNK = 128
G_FFN = 4 * D_MODEL
G_HALF = G_FFN // 2
G_GROUP = 128
G_GROUPS = G_HALF // G_GROUP

FFN_HIDDEN = 4 * D_MODEL

kernel_name = "hybrid_mlstm_sgu_adaln_trunk"


def rmsnorm(x, g):
    xf = x.astype(jnp.float32)
    y = xf * lax.rsqrt(jnp.mean(xf * xf, axis=-1, keepdims=True) + EPS) * g.astype(jnp.float32)
    return y.astype(x.dtype)


def layernorm(x, g, b):
    xf = x.astype(jnp.float32)
    mu = jnp.mean(xf, axis=-1, keepdims=True)
    var = jnp.mean(jnp.square(xf - mu), axis=-1, keepdims=True)
    y = (xf - mu) * lax.rsqrt(var + EPS) * g.astype(jnp.float32) + b.astype(jnp.float32)
    return y.astype(x.dtype)


def _to_chunks(t, nc, d):
    bsz = t.shape[0]
    return t.reshape(bsz, nc, M_CHUNK, M_HEADS, d).transpose(0, 3, 1, 2, 4).astype(jnp.float32)


def mlstm_mixer(h, w_in, b_if, hnorm_g, w_out):
    bsz, s, _ = h.shape
    nc = s // M_CHUNK
    hk = M_HEADS * M_DK
    p = h @ w_in
    q, k, v, o, ig, fg = jnp.split(
        p, [hk, 2 * hk, 2 * hk + D_MODEL, 2 * hk + 2 * D_MODEL, 2 * hk + 2 * D_MODEL + M_HEADS], axis=-1)
    q = _to_chunks(q, nc, M_DK)
    k = _to_chunks(k, nc, M_DK) * (M_DK ** -0.5)
    v = _to_chunks(v, nc, M_DV)
    b_if = b_if.astype(jnp.float32)
    ig = ig.astype(jnp.float32) + b_if[:M_HEADS]
    fg = fg.astype(jnp.float32) + b_if[M_HEADS:]
    ig = GATE_CAP * jnp.tanh(ig / GATE_CAP)
    fg = GATE_CAP * jnp.tanh(fg / GATE_CAP)
    ii = ig.reshape(bsz, nc, M_CHUNK, M_HEADS).transpose(0, 3, 1, 2)
    logf = jax.nn.log_sigmoid(fg).reshape(bsz, nc, M_CHUNK, M_HEADS).transpose(0, 3, 1, 2)

    bcum = jnp.cumsum(logf, axis=-1)
    b_last = bcum[..., -1]

    a = b_last[..., None] - bcum + ii
    m_loc = jnp.max(a, axis=-1)
    wgt = jnp.exp(a - m_loc[..., None])
    c_loc = jnp.einsum('bhcl,bhcld,bhcle->bhcde', wgt, k, v)
    n_loc = jnp.einsum('bhcl,bhcld->bhcd', wgt, k)

    def step(carry, inp):
        c_st, n_st, m_st = carry
        cl, nl, ml, bl = inp
        m_new = jnp.maximum(bl + m_st, ml)
        s_old = jnp.exp(bl + m_st - m_new)
        s_new = jnp.exp(ml - m_new)
        c_new = s_old[..., None, None] * c_st + s_new[..., None, None] * cl
        n_new = s_old[..., None] * n_st + s_new[..., None] * nl
        return (c_new, n_new, m_new), (c_st, n_st, m_st)

    init = (jnp.zeros((bsz, M_HEADS, M_DK, M_DV), jnp.float32),
            jnp.zeros((bsz, M_HEADS, M_DK), jnp.float32),
            jnp.zeros((bsz, M_HEADS), jnp.float32))
    xs = (jnp.moveaxis(c_loc, 2, 0), jnp.moveaxis(n_loc, 2, 0),
          jnp.moveaxis(m_loc, 2, 0), jnp.moveaxis(b_last, 2, 0))
    _, (c_prev, n_prev, m_prev) = lax.scan(step, init, xs)
    c_prev = jnp.moveaxis(c_prev, 0, 2)
    n_prev = jnp.moveaxis(n_prev, 0, 2)
    m_prev = jnp.moveaxis(m_prev, 0, 2)

    causal = jnp.tril(jnp.ones((M_CHUNK, M_CHUNK), dtype=bool))
    dmat = bcum[..., :, None] - bcum[..., None, :] + ii[..., None, :]
    dmat = jnp.where(causal, dmat, -jnp.inf)
    g_inter = bcum + m_prev[..., None]
    m_j = jnp.maximum(g_inter, jnp.max(dmat, axis=-1))
    decay = jnp.exp(dmat - m_j[..., None])
    scores = jnp.einsum('bhcid,bhcjd->bhcij', q, k) * decay
    inter = jnp.exp(g_inter - m_j)
    num = (inter[..., None] * jnp.einsum('bhcid,bhcde->bhcie', q, c_prev)
           + jnp.einsum('bhcij,bhcje->bhcie', scores, v))
    den = inter * jnp.einsum('bhcid,bhcd->bhci', q, n_prev) + jnp.sum(scores, axis=-1)
    hh = num / jnp.maximum(jnp.abs(den), jnp.exp(-m_j))[..., None]

    hh = hh * lax.rsqrt(jnp.mean(hh * hh, axis=-1, keepdims=True) + EPS)
    hh = hh.transpose(0, 2, 3, 1, 4).reshape(bsz, s, M_HEADS * M_DV)
    hh = hh * hnorm_g.astype(jnp.float32)
    out = jax.nn.sigmoid(o.astype(jnp.float32)) * hh
    return out.astype(h.dtype) @ w_out


def sgu_mixer(h, w_in, b_in, ln_g, ln_b, ws, bs, w_out):
    bsz, s, _ = h.shape
    nc = s // G_CHUNK
    z = jax.nn.gelu(h @ w_in + b_in, approximate=False)
    u, v = jnp.split(z, 2, axis=-1)
    v = layernorm(v, ln_g, ln_b)
    vr = v.reshape(bsz, nc, G_CHUNK, G_GROUPS, G_GROUP)
    wm = ws * jnp.tril(jnp.ones((G_CHUNK, G_CHUNK), ws.dtype))
    sv = jnp.einsum('gts,bnsgc->bntgc', wm, vr) + bs.T[:, :, None]
    y = u * sv.reshape(bsz, s, G_HALF)
    return y @ w_out


def setup_inputs(seed: int = 0) -> dict:
    key = jax.random.key(seed)
    ks = jax.random.split(key, 20)
    f32 = jnp.float32
    nrm = lambda k, shape, scale: jax.random.normal(k, shape, f32) * scale
    return {
        "x": nrm(ks[0], (BATCH, SEQ, D_MODEL), 1.0),
        "c": nrm(ks[1], (BATCH, D_MODEL), 1.0),
        "norm_g": 1.0 + nrm(ks[2], (DEPTH, 4, D_MODEL), 0.1),
        "ada_w": nrm(ks[3], (DEPTH, D_MODEL, 6 * D_MODEL), 0.5 * D_MODEL ** -0.5),
        "ada_b": nrm(ks[4], (DEPTH, 6 * D_MODEL), 0.02),
        "ffn_w1": nrm(ks[5], (DEPTH, D_MODEL, FFN_HIDDEN), D_MODEL ** -0.5),
        "ffn_w2": nrm(ks[6], (DEPTH, FFN_HIDDEN, D_MODEL), FFN_HIDDEN ** -0.5),
        "a_w_in": nrm(ks[7], (N_A, D_MODEL, A_IN), D_MODEL ** -0.5),
        "a_b_if": jnp.concatenate([nrm(ks[8], (N_A, M_HEADS), 0.1),
                                   3.0 + nrm(ks[9], (N_A, M_HEADS), 0.5)], axis=-1),
        "a_hnorm_g": 1.0 + nrm(ks[10], (N_A, M_HEADS * M_DV), 0.1),
        "a_w_out": nrm(ks[11], (N_A, M_HEADS * M_DV, D_MODEL), (M_HEADS * M_DV) ** -0.5),
        "b_w_in": nrm(ks[12], (N_B, D_MODEL, G_FFN), D_MODEL ** -0.5),
        "b_b_in": nrm(ks[13], (N_B, G_FFN), 0.02),
        "b_ln_g": 1.0 + nrm(ks[14], (N_B, G_HALF), 0.1),
        "b_ln_b": nrm(ks[15], (N_B, G_HALF), 0.02),
        "b_ws": nrm(ks[16], (N_B, G_GROUPS, G_CHUNK, G_CHUNK), G_CHUNK ** -0.5),
        "b_bs": 1.0 + nrm(ks[17], (N_B, G_GROUPS, G_CHUNK), 0.1),
        "b_w_out": nrm(ks[18], (N_B, G_HALF, D_MODEL), G_HALF ** -0.5),
    }


def reference(x, c, norm_g, ada_w, ada_b, ffn_w1, ffn_w2,
              a_w_in, a_b_if, a_hnorm_g, a_w_out,
              b_w_in, b_b_in, b_ln_g, b_ln_b, b_ws, b_bs, b_w_out):
    c_act = jax.nn.silu(c)
    for i in range(DEPTH):
        mod = c_act @ ada_w[i] + ada_b[i]
        sh1, sc1, g1, sh2, sc2, g2 = jnp.split(mod[:, None, :], 6, axis=-1)
        h = rmsnorm(x, norm_g[i, 0]) * (1.0 + sc1) + sh1
        j = i // N_MIXERS
        if i % N_MIXERS == 0:
            y = mlstm_mixer(h, a_w_in[j], a_b_if[j], a_hnorm_g[j], a_w_out[j])
        else:
            y = sgu_mixer(h, b_w_in[j], b_b_in[j], b_ln_g[j], b_ln_b[j], b_ws[j], b_bs[j], b_w_out[j])
        x = x + g1 * rmsnorm(y, norm_g[i, 1])
        h = rmsnorm(x, norm_g[i, 2]) * (1.0 + sc2) + sh2
        y = jnp.square(jax.nn.relu(h @ ffn_w1[i])) @ ffn_w2[i]
        x = x + g2 * rmsnorm(y, norm_g[i, 3])
    return x
```

```cpp
#include <hip/hip_runtime.h>
#include <cstdio>
#include <cstdint>
namespace pg8 {
#define PG8_LAS __attribute__((address_space(3)))
typedef unsigned short bf16_t;
typedef short bf16x8 __attribute__((ext_vector_type(8)));
typedef float f32x4 __attribute__((ext_vector_type(4)));
typedef unsigned u32x4 __attribute__((ext_vector_type(4)));
constexpr int BM = 256, BK = 64, HALF = 128, HTB = HALF * BK * 2  , STAGE_BYTES = 8 * HTB, NXCD = 8, WGM = 8;

__host__ __device__ __forceinline__ int lds_byte(int r, int c) { const int st = (r >> 4) * 2 + (c >> 5), rr = r & 15, cc = c & 31, ob = rr * 64 + cc * 2; return st * 1024 + (ob ^ (((ob >> 9) & 1) << 5)); }
__host__ __device__ __forceinline__ void stage_rc(int b, int& R, int& C) { const int st = b / 1024, sb = b % 1024, swz = sb ^ (((sb >> 9) & 1) << 5); R = (st >> 1) * 16 + swz / 64; C = (st & 1) * 32 + (swz % 64) / 2; }
__host__ __device__ __forceinline__ int perm32(int rho) { const int n = rho >> 4, i = rho & 15; return 8 * (i >> 2) + 4 * n + (i & 3); }

struct Unit { int pm, pn; };
struct Gemm { const bf16_t* A; const bf16_t* Bt; int M, N, K, lda; };

struct StaticOrder {
    int nM, nN, nwg, G, c;
    __host__ __device__ void init(int M, int N, int G_, int c_) { nM = M / BM; nN = N / BM; nwg = nM * nN; G = G_; c = c_; }
    __host__ __device__ bool next(int i, Unit& u) const {
        const long L = (long)i * G + c; if (L >= nwg) return false;
        int wgid = (int)L; { const int q = nwg / NXCD, r = nwg % NXCD, xcd = wgid % NXCD, off = wgid / NXCD; wgid = (xcd < r ? xcd * (q + 1) : r * (q + 1) + (xcd - r) * q) + off; }
        const int nig = WGM * nN, gid = wgid / nig, fm = gid * WGM, gsz = (nM - fm) < WGM ? (nM - fm) : WGM;
        u.pm = fm + ((wgid % nig) % gsz); u.pn = (wgid % nig) / gsz; return true;
    }
    __device__ __forceinline__ void a_ready(const Unit&) const {}
    __device__ __forceinline__ void done(const Unit&) const {}
};
__device__ __forceinline__ unsigned cvt_pk_bf16(float lo, float hi) { unsigned r; asm volatile("v_cvt_pk_bf16_f32 %0, %1, %2" : "=v"(r) : "v"(lo), "v"(hi)); return r; }
typedef float f32x2 __attribute__((ext_vector_type(2)));
__device__ __forceinline__ f32x2 gelu_pk(f32x2 v) {
    const f32x2 av = __builtin_elementwise_abs(v), d = av * 0.2316418882f + 1.0f;
    f32x2 t; t.x = __builtin_amdgcn_rcpf(d.x); t.y = __builtin_amdgcn_rcpf(d.y);
    f32x2 q = t * 0.5307027145f + (-0.7265760135f); q = q * t + 0.7107068705f; q = q * t + (-0.142248368f); q = q * t + 0.127414796f; q = q * t;
    const f32x2 s = (v * v) * (-0.72134752044f);
    f32x2 e; e.x = __builtin_amdgcn_exp2f(s.x); e.y = __builtin_amdgcn_exp2f(s.y);
    const f32x2 m = v * (q * e), r = v - m;
    f32x2 o; o.x = v.x < 0.f ? m.x : r.x; o.y = v.y < 0.f ? m.y : r.y; return o;
}
template <int ACT  > struct EpiBf16 {
    static constexpr bool PERM = true, AFTER_DRAIN = false;
    bf16_t* O; int ldc;
    __device__ __forceinline__ void operator()(const f32x4 (&acc)[2][2][4][2], const Unit& u, int wr, int wc, int fr, int fq) const {
        const int row0 = u.pm * BM + wr * 64 + fr, col0 = u.pn * BM + wc * 32 + 8 * fq;
#pragma unroll
        for (int ai = 0; ai < 2; ++ai)
#pragma unroll
            for (int m = 0; m < 4; ++m) { bf16_t* rowp = O + (size_t)(row0 + ai * HALF + m * 16) * ldc + col0;
#pragma unroll
                for (int bj = 0; bj < 2; ++bj) { f32x4 v0 = acc[ai][bj][m][0], v1 = acc[ai][bj][m][1];
                    if (ACT == 2) {
#pragma unroll
                        for (int j = 0; j < 4; ++j) { const float a = fmaxf(v0[j], 0.f), b = fmaxf(v1[j], 0.f); v0[j] = a * a; v1[j] = b * b; } }
                    u32x4 w; w.x = cvt_pk_bf16(v0[0], v0[1]); w.y = cvt_pk_bf16(v0[2], v0[3]); w.z = cvt_pk_bf16(v1[0], v1[1]); w.w = cvt_pk_bf16(v1[2], v1[3]);
                    *(u32x4*)(rowp + bj * HALF) = w; } }
    }
};
struct EpiGeluStats {
    static constexpr bool PERM = true, AFTER_DRAIN = false;
    bf16_t* O; int ldc; const float* bias; f32x2* stats;
    __device__ __forceinline__ void operator()(const f32x4 (&acc)[2][2][4][2], const Unit& u, int wr, int wc, int fr, int fq) const {
        const int row0 = u.pm * BM + wr * 64 + fr, col0 = u.pn * BM + wc * 32 + 8 * fq;
        f32x4 bv[2][2];
#pragma unroll
        for (int bj = 0; bj < 2; ++bj)
#pragma unroll
            for (int n = 0; n < 2; ++n) bv[bj][n] = *(const f32x4*)(bias + col0 + bj * HALF + 4 * n);
        const bool vhalf = u.pn >= 8;
#pragma unroll
        for (int ai = 0; ai < 2; ++ai)
#pragma unroll
            for (int m = 0; m < 4; ++m) { const int row = row0 + ai * HALF + m * 16; bf16_t* rowp = O + (size_t)row * ldc + col0; float s = 0.f, s2 = 0.f;
#pragma unroll
                for (int bj = 0; bj < 2; ++bj) { f32x4 v0 = acc[ai][bj][m][0] + bv[bj][0], v1 = acc[ai][bj][m][1] + bv[bj][1];
                    { f32x2 a = gelu_pk((f32x2){v0[0], v0[1]}), b = gelu_pk((f32x2){v0[2], v0[3]}), c = gelu_pk((f32x2){v1[0], v1[1]}), d = gelu_pk((f32x2){v1[2], v1[3]});
                      v0 = (f32x4){a.x, a.y, b.x, b.y}; v1 = (f32x4){c.x, c.y, d.x, d.y}; }
                    s += (v0[0] + v0[1]) + (v0[2] + v0[3]) + (v1[0] + v1[1]) + (v1[2] + v1[3]);
                    s2 += (v0[0] * v0[0] + v0[1] * v0[1]) + (v0[2] * v0[2] + v0[3] * v0[3]) + (v1[0] * v1[0] + v1[1] * v1[1]) + (v1[2] * v1[2] + v1[3] * v1[3]);
                    u32x4 w; w.x = cvt_pk_bf16(v0[0], v0[1]); w.y = cvt_pk_bf16(v0[2], v0[3]); w.z = cvt_pk_bf16(v1[0], v1[1]); w.w = cvt_pk_bf16(v1[2], v1[3]);
                    *(u32x4*)(rowp + bj * HALF) = w; }
                if (vhalf) { s += __shfl_xor(s, 16); s += __shfl_xor(s, 32); s2 += __shfl_xor(s2, 16); s2 += __shfl_xor(s2, 32);
                    if (fq == 0) stats[(size_t)row * 32 + (u.pn - 8) * 4 + wc] = (f32x2){s, s2}; } }
    }
};

template <class Epi, class Sched, bool ALIGN_EPI = false, bool SP2 = false>
__device__ __forceinline__ void gemm_phase(PG8_LAS unsigned char* lds, const Gemm g, const Sched& S, const Epi& E) {
    const int tid = threadIdx.x, wid = __builtin_amdgcn_readfirstlane(tid >> 6), lane = tid & 63, wr = wid >> 2, wc = wid & 3, fr = lane & 15, fq = lane >> 4;
    const int K = g.K, nt = K / BK;
    unsigned voffA[2], voffB[2];
#pragma unroll
    for (int i = 0; i < 2; ++i) { int R, C; stage_rc(tid * 16 + i * 8192, R, C); const int Rb = Epi::PERM ? ((R & ~31) + perm32(R & 31)) : R;
        voffA[i] = (unsigned)(R * g.lda + C) * 2u; voffB[i] = (unsigned)(Rb * K + C) * 2u; }
    const size_t kstep = (size_t)(BK * 2);
    const size_t hstepA = (size_t)HALF * g.lda * 2, hstepB = (size_t)HALF * K * 2;
    const size_t tstepA = 2 * hstepA, tstepB = 2 * hstepB;
    const unsigned ldsw = (unsigned)wid * 1024u;
    const int aoff = lds_byte(wr * 64 + fr, fq * 8), boff = lds_byte(wc * 32 + fr, fq * 8);
#define PG8_SA(b, h) (((b) * 2 + (h)) * HTB)
#define PG8_SB(b, h) ((4 + (b) * 2 + (h)) * HTB)
#define PG8_STAGE(bufoff, gbase, voff) do { _Pragma("unroll") for (int _i = 0; _i < 2; ++_i) \
        __builtin_amdgcn_global_load_lds((const unsigned*)((const char*)(gbase) + (voff)[_i]), (PG8_LAS unsigned*)(lds + (bufoff) + ldsw + _i * 8192), 16, 0, 0); } while (0)
#define PG8_LDA(dst, b, h) do { _Pragma("unroll") for (int m = 0; m < 4; ++m) _Pragma("unroll") for (int k = 0; k < 2; ++k) dst[m][k] = *(const PG8_LAS bf16x8*)(lds + PG8_SA(b, h) + aoff + m * 2048 + k * 1024); } while (0)
#define PG8_LDB(dst, b, h) do { _Pragma("unroll") for (int n = 0; n < 2; ++n) _Pragma("unroll") for (int k = 0; k < 2; ++k) dst[n][k] = *(const PG8_LAS bf16x8*)(lds + PG8_SB(b, h) + boff + n * 2048 + k * 1024); } while (0)
#define PG8_MMA(ai, bj, At, Bt) do { __builtin_amdgcn_s_setprio(1); _Pragma("unroll") for (int m = 0; m < 4; ++m) _Pragma("unroll") for (int n = 0; n < 2; ++n) _Pragma("unroll") for (int k = 0; k < 2; ++k) \
        acc[ai][bj][m][n] = __builtin_amdgcn_mfma_f32_16x16x32_bf16(Bt[n][k], At[m][k], acc[ai][bj][m][n], 0, 0, 0); __builtin_amdgcn_s_setprio(0); } while (0)
#define PG8_WAIT_V(n) asm volatile("s_waitcnt vmcnt(" #n ")" ::: "memory")
#define PG8_WAIT_L(n) asm volatile("s_waitcnt lgkmcnt(" #n ")" ::: "memory")
#define PG8_BAR __builtin_amdgcn_s_barrier()
#define PG8_SCHED __builtin_amdgcn_sched_barrier(0)
    Unit cur, nxt; int ui = 0;
    if (!S.next(0, cur)) return;
    f32x4 acc[2][2][4][2];
#pragma unroll
    for (int a = 0; a < 2; ++a)
#pragma unroll
        for (int b = 0; b < 2; ++b)
#pragma unroll
            for (int m = 0; m < 4; ++m)
#pragma unroll
                for (int n = 0; n < 2; ++n) acc[a][b][m][n] = (f32x4){0.f, 0.f, 0.f, 0.f};
    bf16x8 At[4][2], B0[2][2], B1[2][2];
    const char* cA = (const char*)g.A + (size_t)cur.pm * tstepA; const char* cB = (const char*)g.Bt + (size_t)cur.pn * tstepB;
    S.a_ready(cur);
    if constexpr (SP2) {
        PG8_STAGE(PG8_SB(0, 0), cB, voffB); PG8_STAGE(PG8_SB(0, 1), cB + hstepB, voffB); PG8_STAGE(PG8_SA(0, 0), cA, voffA); PG8_STAGE(PG8_SA(0, 1), cA + hstepA, voffA);
        if (wr == 1) PG8_BAR;
        PG8_WAIT_V(2); PG8_BAR;
        PG8_STAGE(PG8_SB(1, 0), cB + kstep, voffB); PG8_STAGE(PG8_SA(1, 0), cA + kstep, voffA); PG8_STAGE(PG8_SB(1, 1), cB + hstepB + kstep, voffB);
        PG8_WAIT_V(6); PG8_BAR;
    } else {
        PG8_STAGE(PG8_SB(0, 0), cB, voffB); PG8_STAGE(PG8_SA(0, 0), cA, voffA); PG8_STAGE(PG8_SB(0, 1), cB + hstepB, voffB); PG8_STAGE(PG8_SA(0, 1), cA + hstepA, voffA);
        if (wr == 1) PG8_BAR;
        PG8_WAIT_V(4); PG8_BAR;
        PG8_STAGE(PG8_SB(1, 0), cB + kstep, voffB); PG8_STAGE(PG8_SA(1, 0), cA + kstep, voffA); PG8_STAGE(PG8_SB(1, 1), cB + hstepB + kstep, voffB);
        PG8_WAIT_V(6); PG8_BAR;
    }
    for (;;) {
        const bool has_next = S.next(ui + 1, nxt);
        const char* nA = has_next ? (const char*)g.A + (size_t)nxt.pm * tstepA : cA; const char* nB = has_next ? (const char*)g.Bt + (size_t)nxt.pn * tstepB : cB;
        for (int t = 0; t < nt; t += 2) {
            const bool last = (t == nt - 2);
            const char* a1 = cA + (size_t)(t + 1) * kstep;
            const char* a2 = last ? nA : cA + (size_t)(t + 2) * kstep; const char* b2 = last ? nB : cB + (size_t)(t + 2) * kstep;
            const char* a3 = a2 + kstep; const char* b3 = b2 + kstep;
            if (last && has_next) S.a_ready(nxt);
            if constexpr (SP2) {
            PG8_LDB(B0, 0, 0); PG8_LDB(B1, 0, 1); PG8_SCHED; PG8_LDA(At, 0, 0); PG8_STAGE(PG8_SA(1, 1), a1 + hstepA, voffA);
            PG8_WAIT_V(8); PG8_WAIT_L(0); PG8_BAR; PG8_MMA(0, 0, At, B0); PG8_MMA(0, 1, At, B1); PG8_BAR; PG8_SCHED;
            PG8_LDA(At, 0, 1); PG8_STAGE(PG8_SB(0, 0), b2, voffB); PG8_STAGE(PG8_SB(0, 1), b2 + hstepB, voffB); PG8_STAGE(PG8_SA(0, 0), a2, voffA);
            PG8_WAIT_V(8); PG8_WAIT_L(0); PG8_BAR; PG8_MMA(1, 0, At, B0); PG8_MMA(1, 1, At, B1); PG8_BAR; PG8_SCHED;
            PG8_LDB(B0, 1, 0); PG8_LDB(B1, 1, 1); PG8_SCHED; PG8_LDA(At, 1, 0); PG8_STAGE(PG8_SA(0, 1), a2 + hstepA, voffA);
            PG8_WAIT_V(8); PG8_WAIT_L(0); PG8_BAR; PG8_MMA(0, 0, At, B0); PG8_MMA(0, 1, At, B1); PG8_BAR; PG8_SCHED;
            PG8_LDA(At, 1, 1); PG8_STAGE(PG8_SB(1, 0), b3, voffB); PG8_STAGE(PG8_SB(1, 1), b3 + hstepB, voffB); PG8_STAGE(PG8_SA(1, 0), a3, voffA);
            PG8_WAIT_V(8); PG8_WAIT_L(0); PG8_BAR; PG8_MMA(1, 0, At, B0); PG8_MMA(1, 1, At, B1); PG8_BAR; PG8_SCHED;
            } else {
            PG8_LDB(B0, 0, 0); PG8_SCHED; PG8_LDA(At, 0, 0); PG8_STAGE(PG8_SA(1, 1), a1 + hstepA, voffA);
            PG8_WAIT_L(8); PG8_BAR; PG8_WAIT_L(0); PG8_MMA(0, 0, At, B0); PG8_BAR; PG8_SCHED;
            PG8_LDB(B1, 0, 1); PG8_STAGE(PG8_SB(0, 0), b2, voffB);
            PG8_BAR; PG8_WAIT_L(0); PG8_MMA(0, 1, At, B1); PG8_BAR;
            PG8_LDA(At, 0, 1); PG8_STAGE(PG8_SA(0, 0), a2, voffA);
            PG8_BAR; PG8_WAIT_L(0); PG8_MMA(1, 0, At, B0); PG8_BAR; PG8_SCHED;
            PG8_STAGE(PG8_SB(0, 1), b2 + hstepB, voffB);
            PG8_WAIT_V(6); PG8_BAR; PG8_MMA(1, 1, At, B1); PG8_BAR;
            PG8_LDB(B0, 1, 0); PG8_SCHED; PG8_LDA(At, 1, 0); PG8_STAGE(PG8_SA(0, 1), a2 + hstepA, voffA);
            PG8_WAIT_L(8); PG8_BAR; PG8_WAIT_L(0); PG8_MMA(0, 0, At, B0); PG8_BAR; PG8_SCHED;
            PG8_LDB(B1, 1, 1); PG8_STAGE(PG8_SB(1, 0), b3, voffB);
            PG8_BAR; PG8_WAIT_L(0); PG8_MMA(0, 1, At, B1); PG8_BAR;
            PG8_LDA(At, 1, 1); PG8_STAGE(PG8_SA(1, 0), a3, voffA);
            PG8_BAR; PG8_WAIT_L(0); PG8_MMA(1, 0, At, B0); PG8_BAR; PG8_SCHED;
            PG8_STAGE(PG8_SB(1, 1), b3 + hstepB, voffB);
            PG8_WAIT_V(6); PG8_BAR; PG8_MMA(1, 1, At, B1); PG8_BAR;
            }
        }
        if constexpr (ALIGN_EPI) { if (wr == 0) PG8_BAR; }
        if constexpr (!Epi::AFTER_DRAIN) { E(acc, cur, wr, wc, fr, fq); S.done(cur); }
        if (!has_next) break;
#pragma unroll
        for (int a = 0; a < 2; ++a)
#pragma unroll
            for (int b = 0; b < 2; ++b)
#pragma unroll
                for (int m = 0; m < 4; ++m)
#pragma unroll
                    for (int n = 0; n < 2; ++n) acc[a][b][m][n] = (f32x4){0.f, 0.f, 0.f, 0.f};
        cur = nxt; cA = nA; cB = nB; ++ui;
        if constexpr (ALIGN_EPI) { if (wr == 1) PG8_BAR; }
    }
    PG8_WAIT_V(0);
    if constexpr (!ALIGN_EPI) { if (wr == 0) PG8_BAR; }
    PG8_BAR;
    if constexpr (Epi::AFTER_DRAIN) { E.fused(acc, cur, wr, wc, fr, fq, lds, wid, lane); S.done(cur); }
#undef PG8_SA
#undef PG8_SB
#undef PG8_STAGE
#undef PG8_LDA
#undef PG8_LDB
#undef PG8_MMA
#undef PG8_WAIT_V
#undef PG8_WAIT_L
#undef PG8_BAR
#undef PG8_SCHED
}
}
constexpr int NWAVES = 8;
#ifndef MK_N_LAUNCHES
#define MK_N_LAUNCHES 1
#endif
constexpr int NB = 16, SEQ = 2048, D = 1024, M = NB * SEQ, FF = 4096, DEPTH = 4;
constexpr int AIN = 3088, AQ = 3072, NH = 8, DK = 64, DV = 128, CH = 128, NCH = SEQ / CH;
constexpr int GFFN = 4096, GHALF = 2048, NGRP = 16;
constexpr float EPS = 1e-6f, GATE_CAP = 15.0f;
constexpr size_t MiB = 1u << 20;
constexpr size_t WS_CTL = 0, CTL_ZERO_BYTES = 1 * MiB;
constexpr size_t WS_MOD = 1 * MiB;
constexpr size_t WS_GW = 3 * MiB;
constexpr size_t WS_GATES = 6 * MiB;
constexpr size_t WS_STATS = 8 * MiB;
constexpr size_t WS_W1T = 16 * MiB, WS_W2T = 48 * MiB, WS_AWIN = 80 * MiB, WS_AWOUT = 92 * MiB, WS_BWIN = 96 * MiB, WS_BWOUT = 112 * MiB;
constexpr size_t WS_H = 128 * MiB, WS_Y = 192 * MiB, WS_P = 256 * MiB, WS_END = 512 * MiB;
constexpr int CW_TMO = 0, CW_CODE = 1, CW_BAR = 4096;
constexpr int RING_OFF = 0, RING_BYTES = 131072;
constexpr int LDS_BYTES = 147456, LDSCTL_OFF = LDS_BYTES - 512, MISC_OFF = LDSCTL_OFF + 320;

#define GAS __attribute__((address_space(1)))
#define LAS __attribute__((address_space(3)))
typedef unsigned short bf16;
typedef unsigned v4u __attribute__((ext_vector_type(4)));
typedef unsigned v2u __attribute__((ext_vector_type(2)));
typedef float f32x4 __attribute__((ext_vector_type(4)));
typedef float f32x2 __attribute__((ext_vector_type(2)));
typedef short bf16x8 __attribute__((ext_vector_type(8)));
typedef short v4i16_t __attribute__((ext_vector_type(4)));
typedef GAS unsigned gu32;
#define RLX_AGENT __ATOMIC_RELAXED, __HIP_MEMORY_SCOPE_AGENT
#define LDS_WAIT() asm volatile("s_waitcnt lgkmcnt(0)" ::: "memory")
#define VM_WAIT() asm volatile("s_waitcnt vmcnt(0)" ::: "memory")
__device__ __forceinline__ unsigned f2bf(float f) { unsigned u = __builtin_bit_cast(unsigned, f); return (u + 0x7fffu + ((u >> 16) & 1u)) >> 16; }
__device__ __forceinline__ unsigned pk2(float lo, float hi) { return f2bf(lo) | (f2bf(hi) << 16); }
__device__ __forceinline__ float bf2f(unsigned short b) { return __builtin_bit_cast(float, (unsigned)b << 16); }
__device__ __forceinline__ float bflo(unsigned w) { return __builtin_bit_cast(float, w << 16); }
__device__ __forceinline__ float bfhi(unsigned w) { return __builtin_bit_cast(float, w & 0xffff0000u); }
#define XB_TMO      128
#define XB_XCNT(j)  (256  + 64 * (j))
#define XB_XSUB(j)  (1280 + 64 * (j))
#define XB_XGEN(j)  (2304 + 64 * (j))
#define XB_TOP      3328
#define XB_TOPGEN   3392
#define XCD_BAR_WORDS 3456
#define XB_SPIN_CAP (1u << 18)

__device__ __forceinline__ unsigned xb_ld(unsigned* p)              { return __hip_atomic_load(p, __ATOMIC_RELAXED, __HIP_MEMORY_SCOPE_AGENT); }
__device__ __forceinline__ unsigned xb_add(unsigned* p, unsigned v) { return __hip_atomic_fetch_add(p, v, __ATOMIC_RELAXED, __HIP_MEMORY_SCOPE_AGENT); }
__device__ __forceinline__ unsigned xb_xcc_id() { return (unsigned)__builtin_amdgcn_s_getreg((3 << 11) | 20) & 0xFu; }
#define XB_SPIN(cond, bar) do { unsigned _sp = 0; while (cond) { __builtin_amdgcn_s_sleep(1); \
    if ((++_sp & 255u) == 0u) { if (xb_ld(&(bar)[XB_TMO])) break; if (_sp > XB_SPIN_CAP) { atomicAdd(&(bar)[XB_TMO], 1u); break; } } } } while (0)

struct XcdBarrier {
    unsigned* bar; unsigned x;
    volatile LAS unsigned* st;
};

__device__ __forceinline__ XcdBarrier xcd_barrier_post(unsigned* bar, volatile LAS unsigned* st) {
    XcdBarrier b; b.bar = bar; b.x = xb_xcc_id(); b.st = st;
    if (threadIdx.x == 0) (void)xb_add(&bar[XB_XCNT(b.x)], 1u);
    return b;
}
__device__ __forceinline__ void xcd_barrier_complete(unsigned* bar, unsigned x, unsigned& nloc, unsigned& nx) {
    const unsigned G = gridDim.x * gridDim.y * gridDim.z;
    unsigned sum, cnt, mine, sp = 0u;
    for (;;) {
        sum = 0u; cnt = 0u; mine = 0u;
#pragma unroll
        for (unsigned j = 0; j < 16; ++j) { const unsigned c = xb_ld(&bar[XB_XCNT(j)]); sum += c; cnt += (c > 0u) ? 1u : 0u; mine = (j == x) ? c : mine; }
        if (sum == G) break;
        __builtin_amdgcn_s_sleep(1);
        if ((++sp & 255u) == 0u) { if (xb_ld(&bar[XB_TMO])) break; if (sp > XB_SPIN_CAP) { atomicAdd(&bar[XB_TMO], 1u); break; } }
    }
    nloc = mine > 0u ? mine : 1u; nx = cnt > 0u ? cnt : 1u;
}

__device__ __forceinline__ void xcd_barrier(const XcdBarrier& b) {
    asm volatile("s_waitcnt vmcnt(0)" ::: "memory");
    __syncthreads();
    if (threadIdx.x == 0) {
        unsigned* bar = b.bar;
        __builtin_amdgcn_s_waitcnt(0);
        unsigned nloc = b.st[0], nx = b.st[1];
        if (nloc == 0u) { xcd_barrier_complete(bar, b.x, nloc, nx); b.st[0] = nloc; b.st[1] = nx; }
        const unsigned old = xb_add(&bar[XB_XSUB(b.x)], 1u);
        const unsigned gen = old / nloc;
        if (old + 1u == (gen + 1u) * nloc) {
            __builtin_amdgcn_fence(__ATOMIC_RELEASE, "agent");
            asm volatile("s_waitcnt vmcnt(0)" ::: "memory");
            const unsigned og = xb_add(&bar[XB_TOP], 1u);
            const unsigned tg = og / nx;
            if (og + 1u == (tg + 1u) * nx) xb_add(&bar[XB_TOPGEN], 1u);
            else XB_SPIN(xb_ld(&bar[XB_TOPGEN]) == tg, bar);
            __builtin_amdgcn_fence(__ATOMIC_ACQUIRE, "agent");
            xb_add(&bar[XB_XGEN(b.x)], 1u);
            asm volatile("s_waitcnt vmcnt(0)" ::: "memory");
        } else {
            XB_SPIN(xb_ld(&bar[XB_XGEN(b.x)]) == gen, bar);
            __builtin_amdgcn_fence(__ATOMIC_ACQUIRE, "agent");
            asm volatile("s_waitcnt vmcnt(0)" ::: "memory");
        }
    }
    __syncthreads();
}
struct Frame {
    LAS unsigned char* lds;
    volatile LAS unsigned* MISC;
    gu32* ctl;
    int tid, lane, wave;
    int vcu, G;
};
__device__ __forceinline__ float wave_sum(float v) {
#pragma unroll
    for (int o = 1; o < 64; o <<= 1) v += __shfl_xor(v, o);
    return v;
}
__device__ __forceinline__ bf16x8 frag_kc(const LAS unsigned char* base, int row, int k, int stride_bytes) {
    return *(const LAS bf16x8*)(base + row * stride_bytes + k * 2);
}
__device__ __forceinline__ bf16x8 frag_tr(const LAS unsigned char* base, int k0, int n0, int stride_bytes, int lane) {
    const int g = lane >> 4, i = lane & 15;
    const LAS unsigned char* p = base + (k0 + 8 * g + (i >> 2)) * stride_bytes + (n0 + 4 * (i & 3)) * 2;
    const v4i16_t lo = __builtin_amdgcn_ds_read_tr16_b64_v4i16((LAS v4i16_t*)p);
    const v4i16_t hi = __builtin_amdgcn_ds_read_tr16_b64_v4i16((LAS v4i16_t*)(p + 4 * stride_bytes));
    return (bf16x8){lo.x, lo.y, lo.z, lo.w, hi.x, hi.y, hi.z, hi.w};
}
#define MFMA16(a, b, c) __builtin_amdgcn_mfma_f32_16x16x32_bf16((a), (b), (c), 0, 0, 0)

__device__ __forceinline__ void p0_transpose_item(const float* W, int ldw, int K, int ncols, bf16* WT, LAS float* scr, int item, int lane, int sc_lo, int sc_hi, float scl) {
    const int nblk = ncols / 32, kb = item / nblk, nb = item % nblk, k0 = 64 * kb, n0 = 32 * nb;
#pragma unroll 8
    for (int i = 0; i < 32; ++i) { const int kk = 2 * i + (lane >> 5); scr[kk * 33 + (lane & 31)] = W[(size_t)(k0 + kk) * ldw + n0 + (lane & 31)]; }
    LDS_WAIT(); asm volatile("" ::: "memory");
    const int c = lane & 7;
#pragma unroll
    for (int j = 0; j < 4; ++j) { const int n = (lane >> 3) + 8 * j; const LAS float* s = scr + (8 * c) * 33 + n;
        const float f = (n0 + n >= sc_lo && n0 + n < sc_hi) ? scl : 1.0f;
        v4u o; o.x = pk2(s[0 * 33] * f, s[1 * 33] * f); o.y = pk2(s[2 * 33] * f, s[3 * 33] * f); o.z = pk2(s[4 * 33] * f, s[5 * 33] * f); o.w = pk2(s[6 * 33] * f, s[7 * 33] * f);
        *(v4u*)(WT + (size_t)(n0 + n) * K + k0 + 8 * c) = o; }
    LDS_WAIT(); asm volatile("" ::: "memory");
}
struct In {
    const float *x, *c, *norm_g, *ada_w, *ada_b, *ffn_w1, *ffn_w2, *a_w_in, *a_b_if, *a_hnorm_g, *a_w_out, *b_w_in, *b_b_in, *b_ln_g, *b_ln_b, *b_ws, *b_bs, *b_w_out;
};
__device__ __forceinline__ void p0_prologue(Frame& F, const In& I, unsigned char* ws) {
    float* mod = (float*)(ws + WS_MOD);
    for (int task = F.vcu; task < DEPTH * 48; task += F.G) {
        const int li = task / 48, n0 = (task % 48) * 128;
        LAS float* cact = (LAS float*)(F.lds);
        LAS float* part = (LAS float*)(F.lds + 65536);
        for (int i = F.tid; i < NB * D; i += NWAVES * 64) { const int b = i >> 10, k = i & 1023; const float v = I.c[i]; cact[k * 16 + b] = v / (1.0f + __expf(-v)); }
        __syncthreads();
        f32x2 acc[16];
#pragma unroll
        for (int b = 0; b < 16; ++b) acc[b] = (f32x2){0.f, 0.f};
        const float* Wp = I.ada_w + ((size_t)li * D + F.wave * 128) * (6 * D) + n0 + 2 * F.lane;
#pragma unroll 4
        for (int k = 0; k < 128; ++k) {
            const f32x2 wv = *(const f32x2*)(Wp + (size_t)k * (6 * D));
            const LAS f32x4* cp = (const LAS f32x4*)(cact + (F.wave * 128 + k) * 16);
            const f32x4 c0 = cp[0], c1 = cp[1], c2 = cp[2], c3 = cp[3];
            acc[0] += wv * c0[0]; acc[1] += wv * c0[1]; acc[2] += wv * c0[2]; acc[3] += wv * c0[3];
            acc[4] += wv * c1[0]; acc[5] += wv * c1[1]; acc[6] += wv * c1[2]; acc[7] += wv * c1[3];
            acc[8] += wv * c2[0]; acc[9] += wv * c2[1]; acc[10] += wv * c2[2]; acc[11] += wv * c2[3];
            acc[12] += wv * c3[0]; acc[13] += wv * c3[1]; acc[14] += wv * c3[2]; acc[15] += wv * c3[3];
        }
#pragma unroll
        for (int b = 0; b < 16; ++b) *(LAS f32x2*)(part + (F.wave * 16 + b) * 128 + 2 * F.lane) = acc[b];
        __syncthreads();
        for (int idx = F.tid; idx < 16 * 128; idx += NWAVES * 64) { const int b = idx >> 7, n = idx & 127; float s = I.ada_b[li * 6 * D + n0 + n];
#pragma unroll
            for (int w = 0; w < 8; ++w) s += part[(w * 16 + b) * 128 + n];
            mod[((size_t)li * NB + b) * (6 * D) + n0 + n] = s; }
        __syncthreads();
    }
    { float* GW = (float*)(ws + WS_GW); const int gt = F.vcu * NWAVES * 64 + F.tid, NT = F.G * NWAVES * 64;
      for (int i = gt; i < 2 * 16 * D; i += NT) { const int j = i >> 14, g = (i >> 10) & 15, k = i & 1023; GW[i] = I.a_w_in[((size_t)j * D + k) * AIN + AQ + g]; } }
    LAS float* scr = (LAS float*)(F.lds + RING_OFF + F.wave * 16384);
    const int gw = F.vcu * NWAVES + F.wave, NGW = F.G * NWAVES;
    constexpr int I_W1 = (D / 64) * (FF / 32), I_W2 = (FF / 64) * (D / 32), I_AI = (D / 64) * (AQ / 32), I_AO = (D / 64) * (D / 32), I_BI = (D / 64) * (GFFN / 32), I_BO = (GHALF / 64) * (D / 32);
    constexpr int NITEMS = 4 * I_W1 + 4 * I_W2 + 2 * I_AI + 2 * I_AO + 2 * I_BI + 2 * I_BO;
    for (int it = gw; it < NITEMS; it += NGW) {
        int r = it;
        if (r < 4 * I_W1) { const int l = r / I_W1; p0_transpose_item(I.ffn_w1 + (size_t)l * D * FF, FF, D, FF, (bf16*)(ws + WS_W1T) + (size_t)l * D * FF, scr, r % I_W1, F.lane, 0, 0, 1.f); continue; } r -= 4 * I_W1;
        if (r < 4 * I_W2) { const int l = r / I_W2; p0_transpose_item(I.ffn_w2 + (size_t)l * D * FF, D, FF, D, (bf16*)(ws + WS_W2T) + (size_t)l * D * FF, scr, r % I_W2, F.lane, 0, 0, 1.f); continue; } r -= 4 * I_W2;
        if (r < 2 * I_AI) { const int l = r / I_AI; p0_transpose_item(I.a_w_in + (size_t)l * D * AIN, AIN, D, AQ, (bf16*)(ws + WS_AWIN) + (size_t)l * AQ * D, scr, r % I_AI, F.lane, 512, 1024, 0.125f); continue; } r -= 2 * I_AI;
        if (r < 2 * I_AO) { const int l = r / I_AO; p0_transpose_item(I.a_w_out + (size_t)l * D * D, D, D, D, (bf16*)(ws + WS_AWOUT) + (size_t)l * D * D, scr, r % I_AO, F.lane, 0, 0, 1.f); continue; } r -= 2 * I_AO;
        if (r < 2 * I_BI) { const int l = r / I_BI; p0_transpose_item(I.b_w_in + (size_t)l * D * GFFN, GFFN, D, GFFN, (bf16*)(ws + WS_BWIN) + (size_t)l * D * GFFN, scr, r % I_BI, F.lane, 0, 0, 1.f); continue; } r -= 2 * I_BI;
        { const int l = r / I_BO; p0_transpose_item(I.b_w_out + (size_t)l * GHALF * D, D, GHALF, D, (bf16*)(ws + WS_BWOUT) + (size_t)l * GHALF * D, scr, r % I_BO, F.lane, 0, 0, 1.f); }
    }
}

template <bool HAS_Y, bool WRITE_H, bool GATES>
__device__ __forceinline__ void nrn_phase(Frame& F, const float* xin, float* xout, const bf16* Y, bf16* H, const float* ng_a, const float* gmod  ,
                                          const float* ng_b, const float* scmod, const float* shmod, const float* GW  , const float* b_if, float* gates) {
    LAS float* gwl = (LAS float*)(F.lds);
    if (GATES) { for (int i = F.tid; i < 16 * D / 4; i += NWAVES * 64) ((LAS f32x4*)gwl)[i] = ((const f32x4*)GW)[i]; __syncthreads(); }
    const int gw = F.vcu * NWAVES + F.wave, NGW = F.G * NWAVES, lane = F.lane;
#pragma unroll 1
    for (int blk = gw; blk < M / 16; blk += NGW) {
        const int b = (blk * 16) / SEQ;
        f32x4 ga[4], hb[4], hs[4];
#pragma unroll
        for (int j = 0; j < 4; ++j) { const int col = 4 * lane + 256 * j;
            if (HAS_Y) ga[j] = *(const f32x4*)(gmod + (size_t)b * 6 * D + col) * *(const f32x4*)(ng_a + col);
            if (WRITE_H) { hb[j] = *(const f32x4*)(ng_b + col) * (*(const f32x4*)(scmod + (size_t)b * 6 * D + col) + 1.0f); hs[j] = *(const f32x4*)(shmod + (size_t)b * 6 * D + col); } }
#pragma unroll 1
        for (int rr = 0; rr < 16; ++rr) {
            const size_t row = (size_t)blk * 16 + rr;
            f32x4 xv[4];
#pragma unroll
            for (int j = 0; j < 4; ++j) xv[j] = *(const f32x4*)(xin + row * D + 4 * lane + 256 * j);
            if (HAS_Y) {
                f32x4 yv[4]; float s = 0.f;
#pragma unroll
                for (int j = 0; j < 4; ++j) { const v2u w = *(const v2u*)(Y + row * D + 4 * lane + 256 * j); yv[j] = (f32x4){bflo(w.x), bfhi(w.x), bflo(w.y), bfhi(w.y)};
                    s += (yv[j][0] * yv[j][0] + yv[j][1] * yv[j][1]) + (yv[j][2] * yv[j][2] + yv[j][3] * yv[j][3]); }
                const float ry = 1.0f / sqrtf(wave_sum(s) * (1.0f / D) + EPS);
#pragma unroll
                for (int j = 0; j < 4; ++j) { xv[j] = xv[j] + ga[j] * (yv[j] * ry); *(f32x4*)(xout + row * D + 4 * lane + 256 * j) = xv[j]; }
            }
            if (WRITE_H) {
                float s = 0.f;
#pragma unroll
                for (int j = 0; j < 4; ++j) s += (xv[j][0] * xv[j][0] + xv[j][1] * xv[j][1]) + (xv[j][2] * xv[j][2] + xv[j][3] * xv[j][3]);
                const float rx = 1.0f / sqrtf(wave_sum(s) * (1.0f / D) + EPS);
                f32x4 hv[4];
#pragma unroll
                for (int j = 0; j < 4; ++j) { hv[j] = (xv[j] * rx) * hb[j] + hs[j];
                    v2u w; w.x = pk2(hv[j][0], hv[j][1]); w.y = pk2(hv[j][2], hv[j][3]); *(v2u*)(H + row * D + 4 * lane + 256 * j) = w; }
                if (GATES) {
                    float p[16];
#pragma unroll
                    for (int g = 0; g < 16; ++g) { float a = 0.f;
#pragma unroll
                        for (int j = 0; j < 4; ++j) { const f32x4 wv = *(const LAS f32x4*)(gwl + g * D + 4 * lane + 256 * j); a += (hv[j][0] * wv[0] + hv[j][1] * wv[1]) + (hv[j][2] * wv[2] + hv[j][3] * wv[3]); }
                        p[g] = a; asm volatile("" : "+v"(p[g]) :: "memory"); }
                    float q8[8], q4[4], q2[2], q1;
                    { const bool hi = (lane & 32) != 0;
#pragma unroll
                      for (int i = 0; i < 8; ++i) { const float send = hi ? p[i] : p[i + 8], keep = hi ? p[i + 8] : p[i]; q8[i] = keep + __shfl_xor(send, 32); } }
                    { const bool hi = (lane & 16) != 0;
#pragma unroll
                      for (int i = 0; i < 4; ++i) { const float send = hi ? q8[i] : q8[i + 4], keep = hi ? q8[i + 4] : q8[i]; q4[i] = keep + __shfl_xor(send, 16); } }
                    { const bool hi = (lane & 8) != 0;
#pragma unroll
                      for (int i = 0; i < 2; ++i) { const float send = hi ? q4[i] : q4[i + 2], keep = hi ? q4[i + 2] : q4[i]; q2[i] = keep + __shfl_xor(send, 8); } }
                    { const bool hi = (lane & 4) != 0; const float send = hi ? q2[0] : q2[1], keep = hi ? q2[1] : q2[0]; q1 = keep + __shfl_xor(send, 4); }
                    q1 += __shfl_xor(q1, 2); q1 += __shfl_xor(q1, 1);
                    if ((lane & 3) == 0) { const int g = lane >> 2; const float pre = q1 + b_if[g]; const float cp = GATE_CAP * tanhf(pre * (1.0f / GATE_CAP));
                        gates[row * 16 + g] = (g < 8) ? cp : -log1pf(expf(-cp)); }
                }
            }
        }
    }
    if (GATES) __syncthreads();
}
constexpr int ML_QS = 0, ML_KS = 18432, ML_VS = 36864, ML_SS = 75776, ML_CT = 110592, ML_G = 131328;
constexpr int ML_QSTR = 144, ML_VSTR = 304, ML_SSTR = 272, ML_CSTR = 144;
static_assert(ML_G + 4 * 512 + 64 <= LDSCTL_OFF, "mLSTM LDS images fit below the control words");
__device__ __forceinline__ void mlstm_unit(Frame& F, int b, int h, const bf16* P, const float* gates, const float* hng, bf16* HH) {
    const int tid = F.tid, lane = F.lane, w = F.wave, c16 = lane & 15, q = lane >> 4;
    LAS unsigned char* Qs = F.lds + ML_QS; LAS unsigned char* Ks = F.lds + ML_KS; LAS unsigned char* Vs = F.lds + ML_VS;
    LAS unsigned char* Ssw = F.lds + ML_SS + w * (16 * ML_SSTR); LAS unsigned char* Cts = F.lds + ML_CT;
    LAS float* g_bc = (LAS float*)(F.lds + ML_G); LAS float* g_ii = g_bc + 128; LAS float* g_w = g_bc + 256; LAS float* g_eb = g_bc + 384; LAS float* g_tot = g_bc + 512;
    for (int i = tid; i < 144 * ML_CSTR / 4; i += NWAVES * 64) ((LAS unsigned*)Cts)[i] = 0u;
    for (int i = tid; i < 128 * 12; i += NWAVES * 64) { const int l = i / 12, cpair = i % 12; ((LAS unsigned*)(Vs + l * ML_VSTR + 256))[cpair] = (cpair == 0) ? 0x00003F80u : 0u; }
    const int dt = w & 3, eh = w >> 2;
    f32x4 st[5];
#pragma unroll
    for (int k = 0; k < 5; ++k) st[k] = (f32x4){0.f, 0.f, 0.f, 0.f};
    __syncthreads();
    for (int c = 0; c < NCH; ++c) {
        const size_t r0 = (size_t)b * SEQ + (size_t)c * CH;
        float ii_t = 0.f, x = 0.f;
        if (tid < 128) { ii_t = gates[(r0 + tid) * 16 + h]; x = gates[(r0 + tid) * 16 + 8 + h];
#pragma unroll
            for (int o = 1; o < 64; o <<= 1) { const float y = __shfl_up(x, o); if (lane >= o) x += y; }
            if (lane == 63) g_tot[w] = x; }
        v4u qreg[2], kreg[2], vreg[4];
#pragma unroll
        for (int i = 0; i < 2; ++i) { const int ci = tid + 512 * i, l = ci >> 3, ch = ci & 7; const bf16* src = P + (r0 + l) * AQ + h * DK + ch * 8; qreg[i] = *(const v4u*)src; kreg[i] = *(const v4u*)(src + 512); }
#pragma unroll
        for (int i = 0; i < 4; ++i) { const int ci = tid + 512 * i, l = ci >> 4, ch = ci & 15; vreg[i] = *(const v4u*)(P + (r0 + l) * AQ + 1024 + h * DV + ch * 8); }
        __syncthreads();
        const float blast = g_tot[0] + g_tot[1];
        if (tid < 128) { const float bc = x + (w == 1 ? g_tot[0] : 0.f); g_bc[tid] = bc; g_ii[tid] = ii_t; g_w[tid] = expf(blast - bc + ii_t); g_eb[tid] = expf(bc); }
#pragma unroll
        for (int i = 0; i < 2; ++i) { const int ci = tid + 512 * i, l = ci >> 3, ch = ci & 7; *(LAS v4u*)(Qs + l * ML_QSTR + ch * 16) = qreg[i]; *(LAS v4u*)(Ks + l * ML_QSTR + ch * 16) = kreg[i]; }
#pragma unroll
        for (int i = 0; i < 4; ++i) { const int ci = tid + 512 * i, l = ci >> 4, ch = ci & 15; *(LAS v4u*)(Vs + l * ML_VSTR + ch * 16) = vreg[i]; }
        __syncthreads();
        const int irow = 16 * w + c16;
        const float bci = g_bc[irow];
        bf16x8 qf[2]; qf[0] = frag_kc(Qs, irow, 8 * q, ML_QSTR); qf[1] = frag_kc(Qs, irow, 32 + 8 * q, ML_QSTR);
        for (int jt = 0; jt <= w; ++jt) {
            f32x4 s = (f32x4){0.f, 0.f, 0.f, 0.f};
#pragma unroll
            for (int kk = 0; kk < 2; ++kk) { const bf16x8 kf = frag_kc(Ks, 16 * jt + c16, 32 * kk + 8 * q, ML_QSTR); s = MFMA16(kf, qf[kk], s); }
            const f32x4 bcj = *(const LAS f32x4*)(g_bc + 16 * jt + 4 * q), iij = *(const LAS f32x4*)(g_ii + 16 * jt + 4 * q);
#pragma unroll
            for (int r = 0; r < 4; ++r) { const int j = 16 * jt + 4 * q + r; const float d = (j <= irow) ? expf(bci - bcj[r] + iij[r]) : 0.f; s[r] = (j <= irow) ? s[r] * d : 0.f; }
            v2u pw; pw.x = pk2(s[0], s[1]); pw.y = pk2(s[2], s[3]);
            *(LAS v2u*)(Ssw + c16 * ML_SSTR + (16 * jt + 4 * q) * 2) = pw;
        }
        if ((w & 1) == 0) *(LAS v2u*)(Ssw + c16 * ML_SSTR + (16 * (w + 1) + 4 * q) * 2) = (v2u){0u, 0u};
        f32x4 acc[9];
#pragma unroll
        for (int et = 0; et < 9; ++et) { f32x4 a = (f32x4){0.f, 0.f, 0.f, 0.f};
#pragma unroll
            for (int kk = 0; kk < 2; ++kk) { const bf16x8 cf = frag_kc(Cts, 16 * et + c16, 32 * kk + 8 * q, ML_CSTR); a = MFMA16(cf, qf[kk], a); }
            acc[et] = a; }
        { const float ebi = g_eb[irow];
#pragma unroll
          for (int et = 0; et < 9; ++et) acc[et] = acc[et] * ebi; }
        const int nks = (w + 2) >> 1;
        for (int ks = 0; ks < nks; ++ks) {
            const bf16x8 sf = frag_kc(Ssw, c16, 32 * ks + 8 * q, ML_SSTR);
#pragma unroll
            for (int et = 0; et < 9; ++et) { const bf16x8 vf = frag_tr(Vs, 32 * ks, 16 * et, ML_VSTR, lane); acc[et] = MFMA16(vf, sf, acc[et]); }
        }
        { const float den = __shfl(acc[8][0], c16);
          const float inv = 1.0f / fmaxf(fabsf(den), 1.0f);
          float ss = 0.f;
#pragma unroll
          for (int et = 0; et < 8; ++et) { acc[et] = acc[et] * inv; ss += (acc[et][0] * acc[et][0] + acc[et][1] * acc[et][1]) + (acc[et][2] * acc[et][2] + acc[et][3] * acc[et][3]); }
          ss += __shfl_xor(ss, 16); ss += __shfl_xor(ss, 32);
          const float rn = 1.0f / sqrtf(ss * (1.0f / DV) + EPS);
          const size_t row = r0 + irow;
#pragma unroll
          for (int et = 0; et < 8; ++et) { const int e0 = 16 * et + 4 * q;
              const v2u ow = *(const v2u*)(P + row * AQ + 2048 + h * DV + e0);
              const f32x4 gv = *(const f32x4*)(hng + h * DV + e0);
              const float o0 = bflo(ow.x), o1 = bfhi(ow.x), o2 = bflo(ow.y), o3 = bfhi(ow.y);
              const float y0 = acc[et][0] * rn * gv[0] / (1.0f + __expf(-o0)), y1 = acc[et][1] * rn * gv[1] / (1.0f + __expf(-o1));
              const float y2 = acc[et][2] * rn * gv[2] / (1.0f + __expf(-o2)), y3 = acc[et][3] * rn * gv[3] / (1.0f + __expf(-o3));
              v2u pw; pw.x = pk2(y0, y1); pw.y = pk2(y2, y3);
              *(v2u*)(HH + row * D + h * DV + e0) = pw; } }
        __syncthreads();
        { const float dec = expf(blast);
#pragma unroll
          for (int k = 0; k < 5; ++k) st[k] = st[k] * dec;
#pragma unroll
          for (int ks = 0; ks < 4; ++ks) {
              bf16x8 kf = frag_tr(Ks, 32 * ks, 16 * dt, ML_QSTR, lane);
              const f32x4 w0 = *(const LAS f32x4*)(g_w + 32 * ks + 8 * q), w1 = *(const LAS f32x4*)(g_w + 32 * ks + 8 * q + 4);
              { const unsigned a0 = pk2(bf2f((unsigned short)kf[0]) * w0[0], bf2f((unsigned short)kf[1]) * w0[1]), a1 = pk2(bf2f((unsigned short)kf[2]) * w0[2], bf2f((unsigned short)kf[3]) * w0[3]);
                const unsigned a2 = pk2(bf2f((unsigned short)kf[4]) * w1[0], bf2f((unsigned short)kf[5]) * w1[1]), a3 = pk2(bf2f((unsigned short)kf[6]) * w1[2], bf2f((unsigned short)kf[7]) * w1[3]);
                kf = __builtin_bit_cast(bf16x8, (v4u){a0, a1, a2, a3}); }
#pragma unroll
              for (int k = 0; k < 5; ++k) { const int et = eh + 2 * k; if (et < 9) { const bf16x8 vf = frag_tr(Vs, 32 * ks, 16 * et, ML_VSTR, lane); st[k] = MFMA16(kf, vf, st[k]); } }
          }
#pragma unroll
          for (int k = 0; k < 5; ++k) { const int et = eh + 2 * k; if (et < 9) { v2u pw; pw.x = pk2(st[k][0], st[k][1]); pw.y = pk2(st[k][2], st[k][3]);
              *(LAS v2u*)(Cts + (16 * et + c16) * ML_CSTR + (16 * dt + 4 * q) * 2) = pw; } } }
        __syncthreads();
    }
}

constexpr int SG_AS = 0, SG_VS = 34816, SG_F = 69632;
constexpr int SG_STR = 272;
__device__ __forceinline__ void sgu_unit(Frame& F, int b, int n, int g, bf16* Z, const f32x2* stats, const float* wsg  , const float* bsg  , const float* lng, const float* lnb  ) {
    const int tid = F.tid, lane = F.lane, w = F.wave, c16 = lane & 15, q = lane >> 4;
    LAS unsigned char* As = F.lds + SG_AS; LAS unsigned char* Vs = F.lds + SG_VS;
    LAS float* f_mu = (LAS float*)(F.lds + SG_F); LAS float* f_rs = f_mu + 128; LAS float* f_r1 = f_mu + 256; LAS float* f_r2 = f_mu + 384;
    const size_t r0 = (size_t)b * SEQ + (size_t)n * CH;
    v4u vreg[4];
#pragma unroll
    for (int i = 0; i < 4; ++i) { const int ci = tid + 512 * i, l = ci >> 4, ch = ci & 15; vreg[i] = *(const v4u*)(Z + (r0 + l) * GFFN + GHALF + g * 128 + ch * 8); }
    if (tid < 128) { const f32x4* sp = (const f32x4*)(stats + (r0 + tid) * 32); float s = 0.f, s2 = 0.f;
#pragma unroll
        for (int i = 0; i < 16; ++i) { const f32x4 v = sp[i]; s += v[0] + v[2]; s2 += v[1] + v[3]; }
        const float mu = s * (1.0f / GHALF), var = fmaxf(s2 * (1.0f / GHALF) - mu * mu, 0.f);
        f_mu[tid] = mu; f_rs[tid] = 1.0f / sqrtf(var + EPS); }
#pragma unroll
    for (int i = 0; i < 4; ++i) { const int ci = tid + 512 * i, l = ci >> 4, ch = ci & 15; *(LAS v4u*)(Vs + l * SG_STR + ch * 16) = vreg[i]; }
    __syncthreads();
#pragma unroll
    for (int i = 0; i < 4; ++i) { const int ci = tid + 512 * i, t = ci >> 4, s0 = (ci & 15) * 8; float r1 = 0.f, r2 = 0.f; unsigned pw[4] = {0u, 0u, 0u, 0u};
        if (s0 <= t) { const f32x4 a = *(const f32x4*)(wsg + t * 128 + s0), c = *(const f32x4*)(wsg + t * 128 + s0 + 4);
            const f32x4 ra = *(const LAS f32x4*)(f_rs + s0), rc = *(const LAS f32x4*)(f_rs + s0 + 4), ma = *(const LAS f32x4*)(f_mu + s0), mc = *(const LAS f32x4*)(f_mu + s0 + 4);
            float e[8];
#pragma unroll
            for (int k = 0; k < 4; ++k) { const float wa = (s0 + k <= t) ? a[k] : 0.f, wc = (s0 + 4 + k <= t) ? c[k] : 0.f; r2 += wa + wc; e[k] = wa * ra[k]; e[4 + k] = wc * rc[k]; }
#pragma unroll
            for (int k = 0; k < 4; ++k) pw[k] = pk2(e[2 * k], e[2 * k + 1]);
#pragma unroll
            for (int k = 0; k < 4; ++k) { r1 += bflo(pw[k]) * ((2 * k < 4) ? ma[2 * k] : mc[2 * k - 4]) + bfhi(pw[k]) * ((2 * k + 1 < 4) ? ma[2 * k + 1] : mc[2 * k + 1 - 4]); } }
        *(LAS v4u*)(As + t * SG_STR + s0 * 2) = (v4u){pw[0], pw[1], pw[2], pw[3]};
        r1 += __shfl_xor(r1, 1); r1 += __shfl_xor(r1, 2); r1 += __shfl_xor(r1, 4); r1 += __shfl_xor(r1, 8);
        r2 += __shfl_xor(r2, 1); r2 += __shfl_xor(r2, 2); r2 += __shfl_xor(r2, 4); r2 += __shfl_xor(r2, 8);
        if ((ci & 15) == 0) { f_r1[t] = r1; f_r2[t] = r2; } }
    __syncthreads();
    f32x4 acc[8];
#pragma unroll
    for (int ct = 0; ct < 8; ++ct) acc[ct] = (f32x4){0.f, 0.f, 0.f, 0.f};
    const int trow = 16 * w + c16, nks = (w + 2) >> 1;
    for (int ks = 0; ks < nks; ++ks) {
        const bf16x8 af = frag_kc(As, trow, 32 * ks + 8 * q, SG_STR);
#pragma unroll
        for (int ct = 0; ct < 8; ++ct) { const bf16x8 vf = frag_tr(Vs, 32 * ks, 16 * ct, SG_STR, lane); acc[ct] = MFMA16(vf, af, acc[ct]); }
    }
    { const float r1 = f_r1[trow], r2 = f_r2[trow], bsv = bsg[trow]; bf16* urow = Z + (r0 + trow) * GFFN + g * 128;
#pragma unroll
      for (int ct = 0; ct < 8; ++ct) { const int c0 = 16 * ct + 4 * q; const f32x4 lg = *(const f32x4*)(lng + g * 128 + c0), lb = *(const f32x4*)(lnb + g * 128 + c0);
          const v2u uw = *(const v2u*)(urow + c0);
          const float y0 = bflo(uw.x) * (lg[0] * (acc[ct][0] - r1) + lb[0] * r2 + bsv), y1 = bfhi(uw.x) * (lg[1] * (acc[ct][1] - r1) + lb[1] * r2 + bsv);
          const float y2 = bflo(uw.y) * (lg[2] * (acc[ct][2] - r1) + lb[2] * r2 + bsv), y3 = bfhi(uw.y) * (lg[3] * (acc[ct][3] - r1) + lb[3] * r2 + bsv);
          v2u pw; pw.x = pk2(y0, y1); pw.y = pk2(y2, y3); *(v2u*)(urow + c0) = pw; } }
    __syncthreads();
}
struct Args { const float* in[18]; float* out; unsigned char* ws; int ph_lo, ph_hi; };
constexpr int NPHASE = 2 + 2 * 14;
__global__ void __launch_bounds__(NWAVES * 64, 2) trunk_fwd(Args args) {
    extern __shared__ __attribute__((aligned(16))) unsigned char lds[];
    Frame F;
    F.lds = (LAS unsigned char*)lds;
    F.MISC = (volatile LAS unsigned*)(F.lds + MISC_OFF);
    F.tid = threadIdx.x; F.lane = F.tid & 63; F.wave = __builtin_amdgcn_readfirstlane(F.tid >> 6);
    F.G = gridDim.x; { const int bx = blockIdx.x; F.vcu = (F.G % 8 == 0) ? (bx % 8) * (F.G / 8) + bx / 8 : bx; }
    unsigned char* const ws = args.ws;
    F.ctl = (gu32*)(ws + WS_CTL);
    float* const X = args.out;
    for (int u = F.tid; u < (LDS_BYTES - LDSCTL_OFF) / 4; u += NWAVES * 64) ((LAS unsigned*)(F.lds + LDSCTL_OFF))[u] = 0u;
    __syncthreads();
    XcdBarrier bar; bar.bar = (unsigned*)(F.ctl + CW_BAR); bar.x = 0; bar.st = nullptr;
    const bool one_launch = (args.ph_hi - args.ph_lo) > 1;
    if (one_launch) bar = xcd_barrier_post((unsigned*)(F.ctl + CW_BAR), F.MISC + 8);
    const int lo = args.ph_lo, hi = args.ph_hi;
#define ZDEF int z_; asm volatile("s_mov_b32 %0, 0" : "=s"(z_))
#define INP(k) ((const float*)(const GAS float*)args.in[(k) + z_])
#define WSF(off) ((float*)(ws + (size_t)(off) + z_))
#define WSB(off) ((bf16*)(ws + (size_t)(off) + z_))
#define IN(k) (lo <= (k) && (k) < hi)
#define SEAM(k) do { if (IN(k) && IN((k) + 1)) { XcdBarrier b_ = bar; asm volatile("" : "+s"(b_.bar), "+s"(b_.x)); xcd_barrier(b_); } } while (0)
#define GEMM_PHASE(EPI, Aptr, LDA, Bptr, NN, KK, ...) do { pg8::Gemm g_{(const pg8::bf16_t*)(Aptr), (const pg8::bf16_t*)(Bptr), M, (NN), (KK), (LDA)}; pg8::StaticOrder S_; S_.init(M, (NN), F.G, (int)blockIdx.x); \
        EPI E_{__VA_ARGS__}; pg8::gemm_phase<EPI, pg8::StaticOrder, true, true>(F.lds + RING_OFF, g_, S_, E_); } while (0)
    constexpr size_t MODL = (size_t)NB * 6 * D;

    if (IN(0)) { ZDEF; In I;
        I.x = INP(0); I.c = INP(1); I.norm_g = INP(2); I.ada_w = INP(3); I.ada_b = INP(4); I.ffn_w1 = INP(5); I.ffn_w2 = INP(6); I.a_w_in = INP(7); I.a_b_if = INP(8);
        I.a_hnorm_g = INP(9); I.a_w_out = INP(10); I.b_w_in = INP(11); I.b_b_in = INP(12); I.b_ln_g = INP(13); I.b_ln_b = INP(14); I.b_ws = INP(15); I.b_bs = INP(16); I.b_w_out = INP(17);
        p0_prologue(F, I, ws + z_); }
    SEAM(0);
    if (IN(1)) { ZDEF; const float* mod = WSF(WS_MOD);
        nrn_phase<false, true, true>(F, INP(0), nullptr, nullptr, WSB(WS_H), nullptr, nullptr, INP(2) + 0 * D, mod + 1 * D, mod + 0 * D, WSF(WS_GW), INP(8), WSF(WS_GATES)); }
    SEAM(1);
    { constexpr int pr = 0;
        const int pb = 2 + 14 * pr;
        const int la = 2 * pr, lb = 2 * pr + 1;
        if (IN(pb + 0)) { ZDEF; GEMM_PHASE(pg8::EpiBf16<0>, WSB(WS_H), D, WSB(WS_AWIN) + (size_t)pr * AQ * D, AQ, D, (pg8::bf16_t*)WSB(WS_P), AQ); }
        SEAM(pb + 0);
        if (IN(pb + 1)) { ZDEF; const bf16* Pb = WSB(WS_P); const float* gates = WSF(WS_GATES); const float* hng = INP(9) + pr * D; bf16* Hb = WSB(WS_H);
            for (int u = blockIdx.x; u < NB * NH; u += F.G) mlstm_unit(F, u >> 3, u & 7, Pb, gates, hng, Hb); }
        SEAM(pb + 1);
        if (IN(pb + 2)) { ZDEF; GEMM_PHASE(pg8::EpiBf16<0>, WSB(WS_H), D, WSB(WS_AWOUT) + (size_t)pr * D * D, D, D, (pg8::bf16_t*)WSB(WS_Y), D); }
        SEAM(pb + 2);
        if (IN(pb + 3)) { ZDEF; const float* ma = WSF(WS_MOD) + la * MODL; const float* ng = INP(2) + la * 4 * D; const float* xsrc = (pr == 0) ? INP(0) : (const float*)X;
            nrn_phase<true, true, false>(F, xsrc, X, WSB(WS_Y), WSB(WS_H), ng + 1 * D, ma + 2 * D, ng + 2 * D, ma + 4 * D, ma + 3 * D, nullptr, nullptr, nullptr); }
        SEAM(pb + 3);
        if (IN(pb + 4)) { ZDEF; GEMM_PHASE(pg8::EpiBf16<2>, WSB(WS_H), D, WSB(WS_W1T) + (size_t)la * D * FF, FF, D, (pg8::bf16_t*)WSB(WS_P), FF); }
        SEAM(pb + 4);
        if (IN(pb + 5)) { ZDEF; GEMM_PHASE(pg8::EpiBf16<0>, WSB(WS_P), FF, WSB(WS_W2T) + (size_t)la * D * FF, D, FF, (pg8::bf16_t*)WSB(WS_Y), D); }
        SEAM(pb + 5);
        if (IN(pb + 6)) { ZDEF; const float* ma = WSF(WS_MOD) + la * MODL; const float* mb = WSF(WS_MOD) + lb * MODL; const float* ng = INP(2) + la * 4 * D;
            nrn_phase<true, true, false>(F, X, X, WSB(WS_Y), WSB(WS_H), ng + 3 * D, ma + 5 * D, ng + 4 * D, mb + 1 * D, mb + 0 * D, nullptr, nullptr, nullptr); }
        SEAM(pb + 6);
        if (IN(pb + 7)) { ZDEF; GEMM_PHASE(pg8::EpiGeluStats, WSB(WS_H), D, WSB(WS_BWIN) + (size_t)pr * D * GFFN, GFFN, D, (pg8::bf16_t*)WSB(WS_P), GFFN, INP(12) + pr * GFFN, (pg8::f32x2*)WSF(WS_STATS)); }
        SEAM(pb + 7);
        if (IN(pb + 8)) { ZDEF; bf16* Pb = WSB(WS_P); const f32x2* stats = (const f32x2*)WSF(WS_STATS); const float* wsl = INP(15) + (size_t)pr * NGRP * CH * CH; const float* bsl = INP(16) + pr * NGRP * CH;
            const float* lng = INP(13) + pr * GHALF; const float* lnb = INP(14) + pr * GHALF;
            for (int u = F.vcu; u < NB * NCH * NGRP; u += F.G) { const int g = u & 15, n = (u >> 4) & 15, b = u >> 8; sgu_unit(F, b, n, g, Pb, stats, wsl + (size_t)g * CH * CH, bsl + g * CH, lng, lnb); } }
        SEAM(pb + 8);
        if (IN(pb + 9)) { ZDEF; GEMM_PHASE(pg8::EpiBf16<0>, WSB(WS_P), GFFN, WSB(WS_BWOUT) + (size_t)pr * GHALF * D, D, GHALF, (pg8::bf16_t*)WSB(WS_Y), D); }
        SEAM(pb + 9);
        if (IN(pb + 10)) { ZDEF; const float* mb = WSF(WS_MOD) + lb * MODL; const float* ng = INP(2) + lb * 4 * D;
            nrn_phase<true, true, false>(F, X, X, WSB(WS_Y), WSB(WS_H), ng + 1 * D, mb + 2 * D, ng + 2 * D, mb + 4 * D, mb + 3 * D, nullptr, nullptr, nullptr); }
        SEAM(pb + 10);
        if (IN(pb + 11)) { ZDEF; GEMM_PHASE(pg8::EpiBf16<2>, WSB(WS_H), D, WSB(WS_W1T) + (size_t)lb * D * FF, FF, D, (pg8::bf16_t*)WSB(WS_P), FF); }
        SEAM(pb + 11);
        if (IN(pb + 12)) { ZDEF; GEMM_PHASE(pg8::EpiBf16<0>, WSB(WS_P), FF, WSB(WS_W2T) + (size_t)lb * D * FF, D, FF, (pg8::bf16_t*)WSB(WS_Y), D); }
        SEAM(pb + 12);
        if (IN(pb + 13)) { ZDEF; const float* mb = WSF(WS_MOD) + lb * MODL; const float* ng = INP(2) + lb * 4 * D;
            if (pr == 0) { const float* mn = mb + MODL;
                nrn_phase<true, true, true>(F, X, X, WSB(WS_Y), WSB(WS_H), ng + 3 * D, mb + 5 * D, ng + 4 * D, mn + 1 * D, mn + 0 * D, WSF(WS_GW) + 16 * D, INP(8) + 16, WSF(WS_GATES)); }
            else nrn_phase<true, false, false>(F, X, X, WSB(WS_Y), nullptr, ng + 3 * D, mb + 5 * D, nullptr, nullptr, nullptr, nullptr, nullptr, nullptr); }
        SEAM(pb + 13);
        }
    { constexpr int pr = 1;
        const int pb = 2 + 14 * pr;
        const int la = 2 * pr, lb = 2 * pr + 1;
        if (IN(pb + 0)) { ZDEF; GEMM_PHASE(pg8::EpiBf16<0>, WSB(WS_H), D, WSB(WS_AWIN) + (size_t)pr * AQ * D, AQ, D, (pg8::bf16_t*)WSB(WS_P), AQ); }
        SEAM(pb + 0);
        if (IN(pb + 1)) { ZDEF; const bf16* Pb = WSB(WS_P); const float* gates = WSF(WS_GATES); const float* hng = INP(9) + pr * D; bf16* Hb = WSB(WS_H);
            for (int u = blockIdx.x; u < NB * NH; u += F.G) mlstm_unit(F, u >> 3, u & 7, Pb, gates, hng, Hb); }
        SEAM(pb + 1);
        if (IN(pb + 2)) { ZDEF; GEMM_PHASE(pg8::EpiBf16<0>, WSB(WS_H), D, WSB(WS_AWOUT) + (size_t)pr * D * D, D, D, (pg8::bf16_t*)WSB(WS_Y), D); }
        SEAM(pb + 2);
        if (IN(pb + 3)) { ZDEF; const float* ma = WSF(WS_MOD) + la * MODL; const float* ng = INP(2) + la * 4 * D; const float* xsrc = (pr == 0) ? INP(0) : (const float*)X;
            nrn_phase<true, true, false>(F, xsrc, X, WSB(WS_Y), WSB(WS_H), ng + 1 * D, ma + 2 * D, ng + 2 * D, ma + 4 * D, ma + 3 * D, nullptr, nullptr, nullptr); }
        SEAM(pb + 3);
        if (IN(pb + 4)) { ZDEF; GEMM_PHASE(pg8::EpiBf16<2>, WSB(WS_H), D, WSB(WS_W1T) + (size_t)la * D * FF, FF, D, (pg8::bf16_t*)WSB(WS_P), FF); }
        SEAM(pb + 4);
        if (IN(pb + 5)) { ZDEF; GEMM_PHASE(pg8::EpiBf16<0>, WSB(WS_P), FF, WSB(WS_W2T) + (size_t)la * D * FF, D, FF, (pg8::bf16_t*)WSB(WS_Y), D); }
        SEAM(pb + 5);
        if (IN(pb + 6)) { ZDEF; const float* ma = WSF(WS_MOD) + la * MODL; const float* mb = WSF(WS_MOD) + lb * MODL; const float* ng = INP(2) + la * 4 * D;
            nrn_phase<true, true, false>(F, X, X, WSB(WS_Y), WSB(WS_H), ng + 3 * D, ma + 5 * D, ng + 4 * D, mb + 1 * D, mb + 0 * D, nullptr, nullptr, nullptr); }
        SEAM(pb + 6);
        if (IN(pb + 7)) { ZDEF; GEMM_PHASE(pg8::EpiGeluStats, WSB(WS_H), D, WSB(WS_BWIN) + (size_t)pr * D * GFFN, GFFN, D, (pg8::bf16_t*)WSB(WS_P), GFFN, INP(12) + pr * GFFN, (pg8::f32x2*)WSF(WS_STATS)); }
        SEAM(pb + 7);
        if (IN(pb + 8)) { ZDEF; bf16* Pb = WSB(WS_P); const f32x2* stats = (const f32x2*)WSF(WS_STATS); const float* wsl = INP(15) + (size_t)pr * NGRP * CH * CH; const float* bsl = INP(16) + pr * NGRP * CH;
            const float* lng = INP(13) + pr * GHALF; const float* lnb = INP(14) + pr * GHALF;
            for (int u = F.vcu; u < NB * NCH * NGRP; u += F.G) { const int g = u & 15, n = (u >> 4) & 15, b = u >> 8; sgu_unit(F, b, n, g, Pb, stats, wsl + (size_t)g * CH * CH, bsl + g * CH, lng, lnb); } }
        SEAM(pb + 8);
        if (IN(pb + 9)) { ZDEF; GEMM_PHASE(pg8::EpiBf16<0>, WSB(WS_P), GFFN, WSB(WS_BWOUT) + (size_t)pr * GHALF * D, D, GHALF, (pg8::bf16_t*)WSB(WS_Y), D); }
        SEAM(pb + 9);
        if (IN(pb + 10)) { ZDEF; const float* mb = WSF(WS_MOD) + lb * MODL; const float* ng = INP(2) + lb * 4 * D;
            nrn_phase<true, true, false>(F, X, X, WSB(WS_Y), WSB(WS_H), ng + 1 * D, mb + 2 * D, ng + 2 * D, mb + 4 * D, mb + 3 * D, nullptr, nullptr, nullptr); }
        SEAM(pb + 10);
        if (IN(pb + 11)) { ZDEF; GEMM_PHASE(pg8::EpiBf16<2>, WSB(WS_H), D, WSB(WS_W1T) + (size_t)lb * D * FF, FF, D, (pg8::bf16_t*)WSB(WS_P), FF); }
        SEAM(pb + 11);
        if (IN(pb + 12)) { ZDEF; GEMM_PHASE(pg8::EpiBf16<0>, WSB(WS_P), FF, WSB(WS_W2T) + (size_t)lb * D * FF, D, FF, (pg8::bf16_t*)WSB(WS_Y), D); }
        SEAM(pb + 12);
        if (IN(pb + 13)) { ZDEF; const float* mb = WSF(WS_MOD) + lb * MODL; const float* ng = INP(2) + lb * 4 * D;
            if (pr == 0) { const float* mn = mb + MODL;
                nrn_phase<true, true, true>(F, X, X, WSB(WS_Y), WSB(WS_H), ng + 3 * D, mb + 5 * D, ng + 4 * D, mn + 1 * D, mn + 0 * D, WSF(WS_GW) + 16 * D, INP(8) + 16, WSF(WS_GATES)); }
            else nrn_phase<true, false, false>(F, X, X, WSB(WS_Y), nullptr, ng + 3 * D, mb + 5 * D, nullptr, nullptr, nullptr, nullptr, nullptr, nullptr); }
        SEAM(pb + 13);
        }
#undef ZDEF
#undef INP
#undef WSF
#undef WSB
#undef IN
#undef SEAM
#undef GEMM_PHASE
}

extern "C" void kernel_launch(void* const* d_in, const int* in_sizes, int n_in, void* d_out, int out_size, void* d_ws, size_t ws_size, hipStream_t stream) {
    static int grid = 0;
    if (grid == 0) {
        if (n_in != 18 || in_sizes[0] != M * D || out_size != M * D || ws_size < WS_END) { fprintf(stderr, "kernel_launch: unexpected shapes (n_in %d, in0 %d, out %d, ws %zu); nothing launched\n", n_in, n_in > 0 ? in_sizes[0] : -1, out_size, ws_size); grid = -1; return; }
        int dev = 0, cus = 0, per_cu = 0;
        if (hipGetDevice(&dev) != hipSuccess || hipDeviceGetAttribute(&cus, hipDeviceAttributeMultiprocessorCount, dev) != hipSuccess) { grid = -1; return; }
        if (hipFuncSetAttribute((const void*)trunk_fwd, hipFuncAttributeMaxDynamicSharedMemorySize, LDS_BYTES) != hipSuccess) { fprintf(stderr, "kernel_launch: hipFuncSetAttribute failed\n"); grid = -1; return; }
        if (hipOccupancyMaxActiveBlocksPerMultiprocessor(&per_cu, (const void*)trunk_fwd, NWAVES * 64, LDS_BYTES) != hipSuccess || per_cu < 1) fprintf(stderr, "kernel_launch: occupancy query reports %d\n", per_cu);
        (void)hipGetLastError();
        grid = cus;
    }
    if (grid < 0) return;
    if (hipMemsetAsync((char*)d_ws + WS_CTL, 0, CTL_ZERO_BYTES, stream) != hipSuccess) return;
    Args a{};
    for (int i = 0; i < 18; ++i) a.in[i] = (const float*)d_in[i];
    a.out = (float*)d_out; a.ws = (unsigned char*)d_ws;
#if MK_N_LAUNCHES == 1
    a.ph_lo = 0; a.ph_hi = NPHASE;
    hipLaunchKernelGGL(trunk_fwd, dim3(grid), dim3(NWAVES * 64), LDS_BYTES, stream, a);
#else
    for (int p = 0; p < NPHASE; ++p) { a.ph_lo = p; a.ph_hi = p + 1; hipLaunchKernelGGL(trunk_fwd, dim3(grid), dim3(NWAVES * 64), LDS_BYTES, stream, a); }
#endif
}
```

```cpp
#include <hip/hip_runtime.h>
#include <cstdio>
#include <cstdint>
namespace pg8 {
#define PG8_LAS __attribute__((address_space(3)))
typedef unsigned short bf16_t;
typedef short bf16x8 __attribute__((ext_vector_type(8)));
typedef float f32x4 __attribute__((ext_vector_type(4)));
typedef unsigned u32x4 __attribute__((ext_vector_type(4)));
constexpr int BM = 256, BK = 64, HALF = 128, HTB = HALF * BK * 2  , STAGE_BYTES = 8 * HTB, NXCD = 8, WGM = 8;

__host__ __device__ __forceinline__ int lds_byte(int r, int c) { const int st = (r >> 4) * 2 + (c >> 5), rr = r & 15, cc = c & 31, ob = rr * 64 + cc * 2; return st * 1024 + (ob ^ (((ob >> 9) & 1) << 5)); }
__host__ __device__ __forceinline__ void stage_rc(int b, int& R, int& C) { const int st = b / 1024, sb = b % 1024, swz = sb ^ (((sb >> 9) & 1) << 5); R = (st >> 1) * 16 + swz / 64; C = (st & 1) * 32 + (swz % 64) / 2; }
__host__ __device__ __forceinline__ int perm32(int rho) { const int n = rho >> 4, i = rho & 15; return 8 * (i >> 2) + 4 * n + (i & 3); }

struct Unit { int pm, pn; };
struct Gemm { const bf16_t* A; const bf16_t* Bt; int M, N, K, lda; };

struct StaticOrder {
    int nM, nN, nwg, G, c;
    __host__ __device__ void init(int M, int N, int G_, int c_) { nM = M / BM; nN = N / BM; nwg = nM * nN; G = G_; c = c_; }
    __host__ __device__ bool next(int i, Unit& u) const {
        const long L = (long)i * G + c; if (L >= nwg) return false;
        int wgid = (int)L; { const int q = nwg / NXCD, r = nwg % NXCD, xcd = wgid % NXCD, off = wgid / NXCD; wgid = (xcd < r ? xcd * (q + 1) : r * (q + 1) + (xcd - r) * q) + off; }
        const int nig = WGM * nN, gid = wgid / nig, fm = gid * WGM, gsz = (nM - fm) < WGM ? (nM - fm) : WGM;
        u.pm = fm + ((wgid % nig) % gsz); u.pn = (wgid % nig) / gsz; return true;
    }
    __device__ __forceinline__ void a_ready(const Unit&) const {}
    __device__ __forceinline__ void done(const Unit&) const {}
};
__device__ __forceinline__ unsigned cvt_pk_bf16(float lo, float hi) { unsigned r; asm volatile("v_cvt_pk_bf16_f32 %0, %1, %2" : "=v"(r) : "v"(lo), "v"(hi)); return r; }
typedef float f32x2 __attribute__((ext_vector_type(2)));
__device__ __forceinline__ f32x2 gelu_pk(f32x2 v) {
    const f32x2 av = __builtin_elementwise_abs(v), d = av * 0.2316418882f + 1.0f;
    f32x2 t; t.x = __builtin_amdgcn_rcpf(d.x); t.y = __builtin_amdgcn_rcpf(d.y);
    f32x2 q = t * 0.5307027145f + (-0.7265760135f); q = q * t + 0.7107068705f; q = q * t + (-0.142248368f); q = q * t + 0.127414796f; q = q * t;
    const f32x2 s = (v * v) * (-0.72134752044f);
    f32x2 e; e.x = __builtin_amdgcn_exp2f(s.x); e.y = __builtin_amdgcn_exp2f(s.y);
    const f32x2 m = v * (q * e), r = v - m;
    f32x2 o; o.x = v.x < 0.f ? m.x : r.x; o.y = v.y < 0.f ? m.y : r.y; return o;
}
template <int ACT  > struct EpiBf16 {
    static constexpr bool PERM = true, AFTER_DRAIN = false;
    bf16_t* O; int ldc;
    __device__ __forceinline__ void operator()(const f32x4 (&acc)[2][2][4][2], const Unit& u, int wr, int wc, int fr, int fq) const {
        const int row0 = u.pm * BM + wr * 64 + fr, col0 = u.pn * BM + wc * 32 + 8 * fq;
#pragma unroll
        for (int ai = 0; ai < 2; ++ai)
#pragma unroll
            for (int m = 0; m < 4; ++m) { bf16_t* rowp = O + (size_t)(row0 + ai * HALF + m * 16) * ldc + col0;
#pragma unroll
                for (int bj = 0; bj < 2; ++bj) { f32x4 v0 = acc[ai][bj][m][0], v1 = acc[ai][bj][m][1];
                    if (ACT == 2) {
#pragma unroll
                        for (int j = 0; j < 4; ++j) { const float a = fmaxf(v0[j], 0.f), b = fmaxf(v1[j], 0.f); v0[j] = a * a; v1[j] = b * b; } }
                    u32x4 w; w.x = cvt_pk_bf16(v0[0], v0[1]); w.y = cvt_pk_bf16(v0[2], v0[3]); w.z = cvt_pk_bf16(v1[0], v1[1]); w.w = cvt_pk_bf16(v1[2], v1[3]);
                    *(u32x4*)(rowp + bj * HALF) = w; } }
    }
};
struct EpiGeluStats {
    static constexpr bool PERM = true, AFTER_DRAIN = false;
    bf16_t* O; int ldc; const float* bias; f32x2* stats;
    __device__ __forceinline__ void operator()(const f32x4 (&acc)[2][2][4][2], const Unit& u, int wr, int wc, int fr, int fq) const {
        const int row0 = u.pm * BM + wr * 64 + fr, col0 = u.pn * BM + wc * 32 + 8 * fq;
        f32x4 bv[2][2];
#pragma unroll
        for (int bj = 0; bj < 2; ++bj)
#pragma unroll
            for (int n = 0; n < 2; ++n) bv[bj][n] = *(const f32x4*)(bias + col0 + bj * HALF + 4 * n);
        const bool vhalf = u.pn >= 8;
#pragma unroll
        for (int ai = 0; ai < 2; ++ai)
#pragma unroll
            for (int m = 0; m < 4; ++m) { const int row = row0 + ai * HALF + m * 16; bf16_t* rowp = O + (size_t)row * ldc + col0; float s = 0.f, s2 = 0.f;
#pragma unroll
                for (int bj = 0; bj < 2; ++bj) { f32x4 v0 = acc[ai][bj][m][0] + bv[bj][0], v1 = acc[ai][bj][m][1] + bv[bj][1];
                    { f32x2 a = gelu_pk((f32x2){v0[0], v0[1]}), b = gelu_pk((f32x2){v0[2], v0[3]}), c = gelu_pk((f32x2){v1[0], v1[1]}), d = gelu_pk((f32x2){v1[2], v1[3]});
                      v0 = (f32x4){a.x, a.y, b.x, b.y}; v1 = (f32x4){c.x, c.y, d.x, d.y}; }
                    s += (v0[0] + v0[1]) + (v0[2] + v0[3]) + (v1[0] + v1[1]) + (v1[2] + v1[3]);
                    s2 += (v0[0] * v0[0] + v0[1] * v0[1]) + (v0[2] * v0[2] + v0[3] * v0[3]) + (v1[0] * v1[0] + v1[1] * v1[1]) + (v1[2] * v1[2] + v1[3] * v1[3]);
                    u32x4 w; w.x = cvt_pk_bf16(v0[0], v0[1]); w.y = cvt_pk_bf16(v0[2], v0[3]); w.z = cvt_pk_bf16(v1[0], v1[1]); w.w = cvt_pk_bf16(v1[2], v1[3]);
                    *(u32x4*)(rowp + bj * HALF) = w; }
                if (vhalf) { s += __shfl_xor(s, 16); s += __shfl_xor(s, 32); s2 += __shfl_xor(s2, 16); s2 += __shfl_xor(s2, 32);
                    if (fq == 0) stats[(size_t)row * 32 + (u.pn - 8) * 4 + wc] = (f32x2){s, s2}; } }
    }
};

template <class Epi, class Sched, bool ALIGN_EPI = false, bool SP2 = false>
__device__ __forceinline__ void gemm_phase(PG8_LAS unsigned char* lds, const Gemm g, const Sched& S, const Epi& E) {
    const int tid = threadIdx.x, wid = __builtin_amdgcn_readfirstlane(tid >> 6), lane = tid & 63, wr = wid >> 2, wc = wid & 3, fr = lane & 15, fq = lane >> 4;
    const int K = g.K, nt = K / BK;
    unsigned voffA[2], voffB[2];
#pragma unroll
    for (int i = 0; i < 2; ++i) { int R, C; stage_rc(tid * 16 + i * 8192, R, C); const int Rb = Epi::PERM ? ((R & ~31) + perm32(R & 31)) : R;
        voffA[i] = (unsigned)(R * g.lda + C) * 2u; voffB[i] = (unsigned)(Rb * K + C) * 2u; }
    const size_t kstep = (size_t)(BK * 2);
    const size_t hstepA = (size_t)HALF * g.lda * 2, hstepB = (size_t)HALF * K * 2;
    const size_t tstepA = 2 * hstepA, tstepB = 2 * hstepB;
    const unsigned ldsw = (unsigned)wid * 1024u;
    const int aoff = lds_byte(wr * 64 + fr, fq * 8), boff = lds_byte(wc * 32 + fr, fq * 8);
#define PG8_SA(b, h) (((b) * 2 + (h)) * HTB)
#define PG8_SB(b, h) ((4 + (b) * 2 + (h)) * HTB)
#define PG8_STAGE(bufoff, gbase, voff) do { _Pragma("unroll") for (int _i = 0; _i < 2; ++_i) \
        __builtin_amdgcn_global_load_lds((const unsigned*)((const char*)(gbase) + (voff)[_i]), (PG8_LAS unsigned*)(lds + (bufoff) + ldsw + _i * 8192), 16, 0, 0); } while (0)
#define PG8_LDA(dst, b, h) do { _Pragma("unroll") for (int m = 0; m < 4; ++m) _Pragma("unroll") for (int k = 0; k < 2; ++k) dst[m][k] = *(const PG8_LAS bf16x8*)(lds + PG8_SA(b, h) + aoff + m * 2048 + k * 1024); } while (0)
#define PG8_LDB(dst, b, h) do { _Pragma("unroll") for (int n = 0; n < 2; ++n) _Pragma("unroll") for (int k = 0; k < 2; ++k) dst[n][k] = *(const PG8_LAS bf16x8*)(lds + PG8_SB(b, h) + boff + n * 2048 + k * 1024); } while (0)
#define PG8_MMA(ai, bj, At, Bt) do { __builtin_amdgcn_s_setprio(1); _Pragma("unroll") for (int m = 0; m < 4; ++m) _Pragma("unroll") for (int n = 0; n < 2; ++n) _Pragma("unroll") for (int k = 0; k < 2; ++k) \
        acc[ai][bj][m][n] = __builtin_amdgcn_mfma_f32_16x16x32_bf16(Bt[n][k], At[m][k], acc[ai][bj][m][n], 0, 0, 0); __builtin_amdgcn_s_setprio(0); } while (0)
#define PG8_WAIT_V(n) asm volatile("s_waitcnt vmcnt(" #n ")" ::: "memory")
#define PG8_WAIT_L(n) asm volatile("s_waitcnt lgkmcnt(" #n ")" ::: "memory")
#define PG8_BAR __builtin_amdgcn_s_barrier()
#define PG8_SCHED __builtin_amdgcn_sched_barrier(0)
    Unit cur, nxt; int ui = 0;
    if (!S.next(0, cur)) return;
    f32x4 acc[2][2][4][2];
#pragma unroll
    for (int a = 0; a < 2; ++a)
#pragma unroll
        for (int b = 0; b < 2; ++b)
#pragma unroll
            for (int m = 0; m < 4; ++m)
#pragma unroll
                for (int n = 0; n < 2; ++n) acc[a][b][m][n] = (f32x4){0.f, 0.f, 0.f, 0.f};
    bf16x8 At[4][2], B0[2][2], B1[2][2];
    const char* cA = (const char*)g.A + (size_t)cur.pm * tstepA; const char* cB = (const char*)g.Bt + (size_t)cur.pn * tstepB;
    S.a_ready(cur);
    if constexpr (SP2) {
        PG8_STAGE(PG8_SB(0, 0), cB, voffB); PG8_STAGE(PG8_SB(0, 1), cB + hstepB, voffB); PG8_STAGE(PG8_SA(0, 0), cA, voffA); PG8_STAGE(PG8_SA(0, 1), cA + hstepA, voffA);
        if (wr == 1) PG8_BAR;
        PG8_WAIT_V(2); PG8_BAR;
        PG8_STAGE(PG8_SB(1, 0), cB + kstep, voffB); PG8_STAGE(PG8_SA(1, 0), cA + kstep, voffA); PG8_STAGE(PG8_SB(1, 1), cB + hstepB + kstep, voffB);
        PG8_WAIT_V(6); PG8_BAR;
    } else {
        PG8_STAGE(PG8_SB(0, 0), cB, voffB); PG8_STAGE(PG8_SA(0, 0), cA, voffA); PG8_STAGE(PG8_SB(0, 1), cB + hstepB, voffB); PG8_STAGE(PG8_SA(0, 1), cA + hstepA, voffA);
        if (wr == 1) PG8_BAR;
        PG8_WAIT_V(4); PG8_BAR;
        PG8_STAGE(PG8_SB(1, 0), cB + kstep, voffB); PG8_STAGE(PG8_SA(1, 0), cA + kstep, voffA); PG8_STAGE(PG8_SB(1, 1), cB + hstepB + kstep, voffB);
        PG8_WAIT_V(6); PG8_BAR;
    }
    for (;;) {
        const bool has_next = S.next(ui + 1, nxt);
        const char* nA = has_next ? (const char*)g.A + (size_t)nxt.pm * tstepA : cA; const char* nB = has_next ? (const char*)g.Bt + (size_t)nxt.pn * tstepB : cB;
        for (int t = 0; t < nt; t += 2) {
            const bool last = (t == nt - 2);
            const char* a1 = cA + (size_t)(t + 1) * kstep;
            const char* a2 = last ? nA : cA + (size_t)(t + 2) * kstep; const char* b2 = last ? nB : cB + (size_t)(t + 2) * kstep;
            const char* a3 = a2 + kstep; const char* b3 = b2 + kstep;
            if (last && has_next) S.a_ready(nxt);
            if constexpr (SP2) {
            PG8_LDB(B0, 0, 0); PG8_LDB(B1, 0, 1); PG8_SCHED; PG8_LDA(At, 0, 0); PG8_STAGE(PG8_SA(1, 1), a1 + hstepA, voffA);
            PG8_WAIT_V(8); PG8_WAIT_L(0); PG8_BAR; PG8_MMA(0, 0, At, B0); PG8_MMA(0, 1, At, B1); PG8_BAR; PG8_SCHED;
            PG8_LDA(At, 0, 1); PG8_STAGE(PG8_SB(0, 0), b2, voffB); PG8_STAGE(PG8_SB(0, 1), b2 + hstepB, voffB); PG8_STAGE(PG8_SA(0, 0), a2, voffA);
            PG8_WAIT_V(8); PG8_WAIT_L(0); PG8_BAR; PG8_MMA(1, 0, At, B0); PG8_MMA(1, 1, At, B1); PG8_BAR; PG8_SCHED;
            PG8_LDB(B0, 1, 0); PG8_LDB(B1, 1, 1); PG8_SCHED; PG8_LDA(At, 1, 0); PG8_STAGE(PG8_SA(0, 1), a2 + hstepA, voffA);
            PG8_WAIT_V(8); PG8_WAIT_L(0); PG8_BAR; PG8_MMA(0, 0, At, B0); PG8_MMA(0, 1, At, B1); PG8_BAR; PG8_SCHED;
            PG8_LDA(At, 1, 1); PG8_STAGE(PG8_SB(1, 0), b3, voffB); PG8_STAGE(PG8_SB(1, 1), b3 + hstepB, voffB); PG8_STAGE(PG8_SA(1, 0), a3, voffA);
            PG8_WAIT_V(8); PG8_WAIT_L(0); PG8_BAR; PG8_MMA(1, 0, At, B0); PG8_MMA(1, 1, At, B1); PG8_BAR; PG8_SCHED;
            } else {
            PG8_LDB(B0, 0, 0); PG8_SCHED; PG8_LDA(At, 0, 0); PG8_STAGE(PG8_SA(1, 1), a1 + hstepA, voffA);
            PG8_WAIT_L(8); PG8_BAR; PG8_WAIT_L(0); PG8_MMA(0, 0, At, B0); PG8_BAR; PG8_SCHED;
            PG8_LDB(B1, 0, 1); PG8_STAGE(PG8_SB(0, 0), b2, voffB);
            PG8_BAR; PG8_WAIT_L(0); PG8_MMA(0, 1, At, B1); PG8_BAR;
            PG8_LDA(At, 0, 1); PG8_STAGE(PG8_SA(0, 0), a2, voffA);
            PG8_BAR; PG8_WAIT_L(0); PG8_MMA(1, 0, At, B0); PG8_BAR; PG8_SCHED;
            PG8_STAGE(PG8_SB(0, 1), b2 + hstepB, voffB);
            PG8_WAIT_V(6); PG8_BAR; PG8_MMA(1, 1, At, B1); PG8_BAR;
            PG8_LDB(B0, 1, 0); PG8_SCHED; PG8_LDA(At, 1, 0); PG8_STAGE(PG8_SA(0, 1), a2 + hstepA, voffA);
            PG8_WAIT_L(8); PG8_BAR; PG8_WAIT_L(0); PG8_MMA(0, 0, At, B0); PG8_BAR; PG8_SCHED;
            PG8_LDB(B1, 1, 1); PG8_STAGE(PG8_SB(1, 0), b3, voffB);
            PG8_BAR; PG8_WAIT_L(0); PG8_MMA(0, 1, At, B1); PG8_BAR;
            PG8_LDA(At, 1, 1); PG8_STAGE(PG8_SA(1, 0), a3, voffA);
            PG8_BAR; PG8_WAIT_L(0); PG8_MMA(1, 0, At, B0); PG8_BAR; PG8_SCHED;
            PG8_STAGE(PG8_SB(1, 1), b3 + hstepB, voffB);
            PG8_WAIT_V(6); PG8_BAR; PG8_MMA(1, 1, At, B1); PG8_BAR;
            }
        }
        if constexpr (ALIGN_EPI) { if (wr == 0) PG8_BAR; }
        if constexpr (!Epi::AFTER_DRAIN) { E(acc, cur, wr, wc, fr, fq); S.done(cur); }
        if (!has_next) break;
#pragma unroll
        for (int a = 0; a < 2; ++a)
#pragma unroll
            for (int b = 0; b < 2; ++b)
#pragma unroll
                for (int m = 0; m < 4; ++m)
#pragma unroll
                    for (int n = 0; n < 2; ++n) acc[a][b][m][n] = (f32x4){0.f, 0.f, 0.f, 0.f};
        cur = nxt; cA = nA; cB = nB; ++ui;
        if constexpr (ALIGN_EPI) { if (wr == 1) PG8_BAR; }
    }
    PG8_WAIT_V(0);
    if constexpr (!ALIGN_EPI) { if (wr == 0) PG8_BAR; }
    PG8_BAR;
    if constexpr (Epi::AFTER_DRAIN) { E.fused(acc, cur, wr, wc, fr, fq, lds, wid, lane); S.done(cur); }
#undef PG8_SA
#undef PG8_SB
#undef PG8_STAGE
#undef PG8_LDA
#undef PG8_LDB
#undef PG8_MMA
#undef PG8_WAIT_V
#undef PG8_WAIT_L
#undef PG8_BAR
#undef PG8_SCHED
}
}
constexpr int NWAVES = 8;
#ifndef MK_N_LAUNCHES
#define MK_N_LAUNCHES 1
#endif
constexpr int NB = 16, SEQ = 2048, D = 1024, M = NB * SEQ, FF = 4096, DEPTH = 4;
constexpr int AIN = 3088, AQ = 3072, NH = 8, DK = 64, DV = 128, CH = 128, NCH = SEQ / CH;
constexpr int GFFN = 4096, GHALF = 2048, NGRP = 16;
constexpr float EPS = 1e-6f, GATE_CAP = 15.0f;
constexpr size_t MiB = 1u << 20;
constexpr size_t WS_CTL = 0, CTL_ZERO_BYTES = 1 * MiB;
constexpr size_t WS_MOD = 1 * MiB;
constexpr size_t WS_GW = 3 * MiB;
constexpr size_t WS_GATES = 6 * MiB;
constexpr size_t WS_STATS = 8 * MiB;
constexpr size_t WS_W1T = 16 * MiB, WS_W2T = 48 * MiB, WS_AWIN = 80 * MiB, WS_AWOUT = 92 * MiB, WS_BWIN = 96 * MiB, WS_BWOUT = 112 * MiB;
constexpr size_t WS_H = 128 * MiB, WS_X = 192 * MiB, WS_P = 256 * MiB, WS_END = 512 * MiB;
constexpr int CW_TMO = 0, CW_CODE = 1, CW_BAR = 4096;
constexpr int RING_OFF = 0, RING_BYTES = 131072;
constexpr int LDS_BYTES = 147456, LDSCTL_OFF = LDS_BYTES - 512, MISC_OFF = LDSCTL_OFF + 320;

#define GAS __attribute__((address_space(1)))
#define LAS __attribute__((address_space(3)))
typedef unsigned short bf16;
typedef unsigned v4u __attribute__((ext_vector_type(4)));
typedef unsigned v2u __attribute__((ext_vector_type(2)));
typedef float f32x4 __attribute__((ext_vector_type(4)));
typedef float f32x2 __attribute__((ext_vector_type(2)));
typedef short bf16x8 __attribute__((ext_vector_type(8)));
typedef short v4i16_t __attribute__((ext_vector_type(4)));
typedef GAS unsigned gu32;
#define RLX_AGENT __ATOMIC_RELAXED, __HIP_MEMORY_SCOPE_AGENT
#define LDS_WAIT() asm volatile("s_waitcnt lgkmcnt(0)" ::: "memory")
#define VM_WAIT() asm volatile("s_waitcnt vmcnt(0)" ::: "memory")
__device__ __forceinline__ unsigned f2bf(float f) { unsigned u = __builtin_bit_cast(unsigned, f); return (u + 0x7fffu + ((u >> 16) & 1u)) >> 16; }
__device__ __forceinline__ unsigned pk2(float lo, float hi) { return f2bf(lo) | (f2bf(hi) << 16); }
__device__ __forceinline__ float bf2f(unsigned short b) { return __builtin_bit_cast(float, (unsigned)b << 16); }
__device__ __forceinline__ float bflo(unsigned w) { return __builtin_bit_cast(float, w << 16); }
__device__ __forceinline__ float bfhi(unsigned w) { return __builtin_bit_cast(float, w & 0xffff0000u); }
#define XB_TMO      128
#define XB_XCNT(j)  (256  + 64 * (j))
#define XB_XSUB(j)  (1280 + 64 * (j))
#define XB_XGEN(j)  (2304 + 64 * (j))
#define XB_TOP      3328
#define XB_TOPGEN   3392
#define XCD_BAR_WORDS 3456
#define XB_SPIN_CAP (1u << 18)

__device__ __forceinline__ unsigned xb_ld(unsigned* p)              { return __hip_atomic_load(p, __ATOMIC_RELAXED, __HIP_MEMORY_SCOPE_AGENT); }
__device__ __forceinline__ unsigned xb_add(unsigned* p, unsigned v) { return __hip_atomic_fetch_add(p, v, __ATOMIC_RELAXED, __HIP_MEMORY_SCOPE_AGENT); }
__device__ __forceinline__ unsigned xb_xcc_id() { return (unsigned)__builtin_amdgcn_s_getreg((3 << 11) | 20) & 0xFu; }
#define XB_SPIN(cond, bar) do { unsigned _sp = 0; while (cond) { __builtin_amdgcn_s_sleep(1); \
    if ((++_sp & 255u) == 0u) { if (xb_ld(&(bar)[XB_TMO])) break; if (_sp > XB_SPIN_CAP) { atomicAdd(&(bar)[XB_TMO], 1u); break; } } } } while (0)

struct XcdBarrier {
    unsigned* bar; unsigned x;
    volatile LAS unsigned* st;
};

__device__ __forceinline__ XcdBarrier xcd_barrier_post(unsigned* bar, volatile LAS unsigned* st) {
    XcdBarrier b; b.bar = bar; b.x = xb_xcc_id(); b.st = st;
    if (threadIdx.x == 0) (void)xb_add(&bar[XB_XCNT(b.x)], 1u);
    return b;
}
__device__ __forceinline__ void xcd_barrier_complete(unsigned* bar, unsigned x, unsigned& nloc, unsigned& nx) {
    const unsigned G = gridDim.x * gridDim.y * gridDim.z;
    unsigned sum, cnt, mine, sp = 0u;
    for (;;) {
        sum = 0u; cnt = 0u; mine = 0u;
#pragma unroll
        for (unsigned j = 0; j < 16; ++j) { const unsigned c = xb_ld(&bar[XB_XCNT(j)]); sum += c; cnt += (c > 0u) ? 1u : 0u; mine = (j == x) ? c : mine; }
        if (sum == G) break;
        __builtin_amdgcn_s_sleep(1);
        if ((++sp & 255u) == 0u) { if (xb_ld(&bar[XB_TMO])) break; if (sp > XB_SPIN_CAP) { atomicAdd(&bar[XB_TMO], 1u); break; } }
    }
    nloc = mine > 0u ? mine : 1u; nx = cnt > 0u ? cnt : 1u;
}

__device__ __forceinline__ void xcd_barrier(const XcdBarrier& b) {
    asm volatile("s_waitcnt vmcnt(0)" ::: "memory");
    __syncthreads();
    if (threadIdx.x == 0) {
        unsigned* bar = b.bar;
        __builtin_amdgcn_s_waitcnt(0);
        unsigned nloc = b.st[0], nx = b.st[1];
        if (nloc == 0u) { xcd_barrier_complete(bar, b.x, nloc, nx); b.st[0] = nloc; b.st[1] = nx; }
        const unsigned old = xb_add(&bar[XB_XSUB(b.x)], 1u);
        const unsigned gen = old / nloc;
        if (old + 1u == (gen + 1u) * nloc) {
            __builtin_amdgcn_fence(__ATOMIC_RELEASE, "agent");
            asm volatile("s_waitcnt vmcnt(0)" ::: "memory");
            const unsigned og = xb_add(&bar[XB_TOP], 1u);
            const unsigned tg = og / nx;
            if (og + 1u == (tg + 1u) * nx) xb_add(&bar[XB_TOPGEN], 1u);
            else XB_SPIN(xb_ld(&bar[XB_TOPGEN]) == tg, bar);
            __builtin_amdgcn_fence(__ATOMIC_ACQUIRE, "agent");
            xb_add(&bar[XB_XGEN(b.x)], 1u);
            asm volatile("s_waitcnt vmcnt(0)" ::: "memory");
        } else {
            XB_SPIN(xb_ld(&bar[XB_XGEN(b.x)]) == gen, bar);
            __builtin_amdgcn_fence(__ATOMIC_ACQUIRE, "agent");
            asm volatile("s_waitcnt vmcnt(0)" ::: "memory");
        }
    }
    __syncthreads();
}
struct Frame {
    LAS unsigned char* lds;
    volatile LAS unsigned* MISC;
    gu32* ctl;
    int tid, lane, wave;
    int vcu, G;
};
__device__ __forceinline__ float wave_sum(float v) {
#pragma unroll
    for (int o = 1; o < 64; o <<= 1) v += __shfl_xor(v, o);
    return v;
}
__device__ __forceinline__ bf16x8 frag_kc(const LAS unsigned char* base, int row, int k, int stride_bytes) {
    return *(const LAS bf16x8*)(base + row * stride_bytes + k * 2);
}
__device__ __forceinline__ bf16x8 frag_tr(const LAS unsigned char* base, int k0, int n0, int stride_bytes, int lane) {
    const int g = lane >> 4, i = lane & 15;
    const LAS unsigned char* p = base + (k0 + 8 * g + (i >> 2)) * stride_bytes + (n0 + 4 * (i & 3)) * 2;
    const v4i16_t lo = __builtin_amdgcn_ds_read_tr16_b64_v4i16((LAS v4i16_t*)p);
    const v4i16_t hi = __builtin_amdgcn_ds_read_tr16_b64_v4i16((LAS v4i16_t*)(p + 4 * stride_bytes));
    return (bf16x8){lo.x, lo.y, lo.z, lo.w, hi.x, hi.y, hi.z, hi.w};
}
#define MFMA16(a, b, c) __builtin_amdgcn_mfma_f32_16x16x32_bf16((a), (b), (c), 0, 0, 0)

__device__ __forceinline__ void p0_transpose_item(const float* W, int ldw, int K, int ncols, bf16* WT, LAS float* scr, int item, int lane, int sc_lo, int sc_hi, float scl) {
    const int nblk = ncols / 32, kb = item / nblk, nb = item % nblk, k0 = 64 * kb, n0 = 32 * nb;
#pragma unroll
    for (int i = 0; i < 32; ++i) { const int kk = 2 * i + (lane >> 5); scr[kk * 33 + (lane & 31)] = W[(size_t)(k0 + kk) * ldw + n0 + (lane & 31)]; }
    LDS_WAIT(); asm volatile("" ::: "memory");
    const int c = lane & 7;
#pragma unroll
    for (int j = 0; j < 4; ++j) { const int n = (lane >> 3) + 8 * j; const LAS float* s = scr + (8 * c) * 33 + n;
        const float f = (n0 + n >= sc_lo && n0 + n < sc_hi) ? scl : 1.0f;
        v4u o; o.x = pk2(s[0 * 33] * f, s[1 * 33] * f); o.y = pk2(s[2 * 33] * f, s[3 * 33] * f); o.z = pk2(s[4 * 33] * f, s[5 * 33] * f); o.w = pk2(s[6 * 33] * f, s[7 * 33] * f);
        *(v4u*)(WT + (size_t)(n0 + n) * K + k0 + 8 * c) = o; }
    LDS_WAIT(); asm volatile("" ::: "memory");
}
struct In {
    const float *x, *c, *norm_g, *ada_w, *ada_b, *ffn_w1, *ffn_w2, *a_w_in, *a_b_if, *a_hnorm_g, *a_w_out, *b_w_in, *b_b_in, *b_ln_g, *b_ln_b, *b_ws, *b_bs, *b_w_out;
};
__device__ __forceinline__ void p0_prologue(Frame& F, const In& I, unsigned char* ws) {
    float* mod = (float*)(ws + WS_MOD);
    for (int task = F.vcu; task < DEPTH * 64; task += F.G) {
        const int li = task / 64, n0 = (task % 64) * 96;
        LAS float* cact = (LAS float*)(F.lds);
        LAS float* part = (LAS float*)(F.lds + 65536);
        for (int i = F.tid; i < NB * D; i += NWAVES * 64) { const int b = i >> 10, k = i & 1023; const float v = I.c[i]; cact[k * 16 + b] = v / (1.0f + __expf(-v)); }
        __syncthreads();
        f32x2 acc[16];
#pragma unroll
        for (int b = 0; b < 16; ++b) acc[b] = (f32x2){0.f, 0.f};
        const int ln = F.lane < 48 ? F.lane : 47;
        const float* Wp = I.ada_w + ((size_t)li * D + F.wave * 128) * (6 * D) + n0 + 2 * ln;
#pragma unroll 16
        for (int k = 0; k < 128; ++k) {
            const f32x2 wv = *(const f32x2*)(Wp + (size_t)k * (6 * D));
            const LAS f32x4* cp = (const LAS f32x4*)(cact + (F.wave * 128 + k) * 16);
            const f32x4 c0 = cp[0], c1 = cp[1], c2 = cp[2], c3 = cp[3];
            acc[0] += wv * c0[0]; acc[1] += wv * c0[1]; acc[2] += wv * c0[2]; acc[3] += wv * c0[3];
            acc[4] += wv * c1[0]; acc[5] += wv * c1[1]; acc[6] += wv * c1[2]; acc[7] += wv * c1[3];
            acc[8] += wv * c2[0]; acc[9] += wv * c2[1]; acc[10] += wv * c2[2]; acc[11] += wv * c2[3];
            acc[12] += wv * c3[0]; acc[13] += wv * c3[1]; acc[14] += wv * c3[2]; acc[15] += wv * c3[3];
        }
#pragma unroll
        for (int b = 0; b < 16; ++b) *(LAS f32x2*)(part + (F.wave * 16 + b) * 128 + 2 * ln) = acc[b];
        __syncthreads();
        for (int idx = F.tid; idx < 16 * 96; idx += NWAVES * 64) { const int b = idx / 96, n = idx % 96; float s = I.ada_b[li * 6 * D + n0 + n];
#pragma unroll
            for (int w = 0; w < 8; ++w) s += part[(w * 16 + b) * 128 + n];
            mod[((size_t)li * NB + b) * (6 * D) + n0 + n] = s; }
        __syncthreads();
    }
    { float* GW = (float*)(ws + WS_GW); const int gt = F.vcu * NWAVES * 64 + F.tid, NT = F.G * NWAVES * 64;
      for (int i = gt; i < 2 * 16 * D; i += NT) { const int j = i >> 14, g = (i >> 10) & 15, k = i & 1023; GW[i] = I.a_w_in[((size_t)j * D + k) * AIN + AQ + g]; } }
    LAS float* scr = (LAS float*)(F.lds + RING_OFF + F.wave * 16384);
    const int gw = F.vcu * NWAVES + F.wave, NGW = F.G * NWAVES;
    constexpr int I_W1 = (D / 64) * (FF / 32), I_W2 = (FF / 64) * (D / 32), I_AI = (D / 64) * (AQ / 32), I_AO = (D / 64) * (D / 32), I_BI = (D / 64) * (GFFN / 32), I_BO = (GHALF / 64) * (D / 32);
    constexpr int NITEMS = 4 * I_W1 + 4 * I_W2 + 2 * I_AI + 2 * I_AO + 2 * I_BI + 2 * I_BO;
    for (int it = gw; it < NITEMS; it += NGW) {
        int r = it;
        if (r < 4 * I_W1) { const int l = r / I_W1; p0_transpose_item(I.ffn_w1 + (size_t)l * D * FF, FF, D, FF, (bf16*)(ws + WS_W1T) + (size_t)l * D * FF, scr, r % I_W1, F.lane, 0, 0, 1.f); continue; } r -= 4 * I_W1;
        if (r < 4 * I_W2) { const int l = r / I_W2; p0_transpose_item(I.ffn_w2 + (size_t)l * D * FF, D, FF, D, (bf16*)(ws + WS_W2T) + (size_t)l * D * FF, scr, r % I_W2, F.lane, 0, 0, 1.f); continue; } r -= 4 * I_W2;
        if (r < 2 * I_AI) { const int l = r / I_AI; p0_transpose_item(I.a_w_in + (size_t)l * D * AIN, AIN, D, AQ, (bf16*)(ws + WS_AWIN) + (size_t)l * AQ * D, scr, r % I_AI, F.lane, 512, 1024, 0.125f); continue; } r -= 2 * I_AI;
        if (r < 2 * I_AO) { const int l = r / I_AO; p0_transpose_item(I.a_w_out + (size_t)l * D * D, D, D, D, (bf16*)(ws + WS_AWOUT) + (size_t)l * D * D, scr, r % I_AO, F.lane, 0, 0, 1.f); continue; } r -= 2 * I_AO;
        if (r < 2 * I_BI) { const int l = r / I_BI; p0_transpose_item(I.b_w_in + (size_t)l * D * GFFN, GFFN, D, GFFN, (bf16*)(ws + WS_BWIN) + (size_t)l * D * GFFN, scr, r % I_BI, F.lane, 0, 0, 1.f); continue; } r -= 2 * I_BI;
        { const int l = r / I_BO; p0_transpose_item(I.b_w_out + (size_t)l * GHALF * D, D, GHALF, D, (bf16*)(ws + WS_BWOUT) + (size_t)l * GHALF * D, scr, r % I_BO, F.lane, 0, 0, 1.f); }
    }
}

template <bool HAS_Y, bool WRITE_H, bool GATES, bool XIN_F32, bool XOUT_F32>
__device__ __forceinline__ void nrn_phase(Frame& F, const void* xin_, void* xout_, const bf16* Y, bf16* H, const float* ng_a, const float* gmod  ,
                                          const float* ng_b, const float* scmod, const float* shmod, const float* GW  , const float* b_if, float* gates) {
    LAS float* gwl = (LAS float*)(F.lds);
    const float* xin = (const float*)xin_; const bf16* xinb = (const bf16*)xin_; float* xout = (float*)xout_; bf16* xoutb = (bf16*)xout_;
#define NRN_LDX(dst, row_) do { _Pragma("unroll") for (int j = 0; j < 4; ++j) { if (XIN_F32) dst[j] = *(const f32x4*)(xin + (row_) * D + 4 * lane + 256 * j); \
        else { const v2u w_ = *(const v2u*)(xinb + (row_) * D + 4 * lane + 256 * j); dst[j] = (f32x4){bflo(w_.x), bfhi(w_.x), bflo(w_.y), bfhi(w_.y)}; } } } while (0)
    if (GATES) { for (int i = F.tid; i < 16 * D / 4; i += NWAVES * 64) ((LAS f32x4*)gwl)[i] = ((const f32x4*)GW)[i]; __syncthreads(); }
    const int gw = F.vcu * NWAVES + F.wave, NGW = F.G * NWAVES, lane = F.lane;
#pragma unroll 1
    for (int blk = gw; blk < M / 16; blk += NGW) {
        const int b = (blk * 16) / SEQ;
        f32x4 ga[4], hb[4], hs[4];
#pragma unroll
        for (int j = 0; j < 4; ++j) { const int col = 4 * lane + 256 * j;
            if (HAS_Y) ga[j] = *(const f32x4*)(gmod + (size_t)b * 6 * D + col) * *(const f32x4*)(ng_a + col);
            if (WRITE_H) { hb[j] = *(const f32x4*)(ng_b + col) * (*(const f32x4*)(scmod + (size_t)b * 6 * D + col) + 1.0f); hs[j] = *(const f32x4*)(shmod + (size_t)b * 6 * D + col); } }
        f32x4 xn[4]; v2u yn[4];
        { const size_t row = (size_t)blk * 16;
#pragma unroll
          for (int j = 0; j < 4; ++j) { if (HAS_Y) yn[j] = *(const v2u*)(Y + row * D + 4 * lane + 256 * j); }
          NRN_LDX(xn, row); }
#pragma unroll 1
        for (int rr = 0; rr < 16; ++rr) {
            const size_t row = (size_t)blk * 16 + rr;
            f32x4 xv[4]; v2u yw[4];
#pragma unroll
            for (int j = 0; j < 4; ++j) { xv[j] = xn[j]; if (HAS_Y) yw[j] = yn[j]; }
            if (rr + 1 < 16) {
#pragma unroll
                for (int j = 0; j < 4; ++j) { if (HAS_Y) yn[j] = *(const v2u*)(Y + (row + 1) * D + 4 * lane + 256 * j); }
                NRN_LDX(xn, row + 1); }
            if (HAS_Y) {
                f32x4 yv[4]; float s = 0.f;
#pragma unroll
                for (int j = 0; j < 4; ++j) { const v2u w = yw[j]; yv[j] = (f32x4){bflo(w.x), bfhi(w.x), bflo(w.y), bfhi(w.y)};
                    s += (yv[j][0] * yv[j][0] + yv[j][1] * yv[j][1]) + (yv[j][2] * yv[j][2] + yv[j][3] * yv[j][3]); }
                const float ry = 1.0f / sqrtf(wave_sum(s) * (1.0f / D) + EPS);
#pragma unroll
                for (int j = 0; j < 4; ++j) { xv[j] = xv[j] + ga[j] * (yv[j] * ry);
                    if (XOUT_F32) *(f32x4*)(xout + row * D + 4 * lane + 256 * j) = xv[j];
                    else { v2u w_; w_.x = pk2(xv[j][0], xv[j][1]); w_.y = pk2(xv[j][2], xv[j][3]); *(v2u*)(xoutb + row * D + 4 * lane + 256 * j) = w_; } }
            }
            if (WRITE_H) {
                float s = 0.f;
#pragma unroll
                for (int j = 0; j < 4; ++j) s += (xv[j][0] * xv[j][0] + xv[j][1] * xv[j][1]) + (xv[j][2] * xv[j][2] + xv[j][3] * xv[j][3]);
                const float rx = 1.0f / sqrtf(wave_sum(s) * (1.0f / D) + EPS);
                f32x4 hv[4];
#pragma unroll
                for (int j = 0; j < 4; ++j) { hv[j] = (xv[j] * rx) * hb[j] + hs[j];
                    v2u w; w.x = pk2(hv[j][0], hv[j][1]); w.y = pk2(hv[j][2], hv[j][3]); *(v2u*)(H + row * D + 4 * lane + 256 * j) = w; }
                if (GATES) {
                    float p[16];
#pragma unroll
                    for (int g = 0; g < 16; ++g) { float a = 0.f;
#pragma unroll
                        for (int j = 0; j < 4; ++j) { const f32x4 wv = *(const LAS f32x4*)(gwl + g * D + 4 * lane + 256 * j); a += (hv[j][0] * wv[0] + hv[j][1] * wv[1]) + (hv[j][2] * wv[2] + hv[j][3] * wv[3]); }
                        p[g] = a; asm volatile("" : "+v"(p[g]) :: "memory"); }
                    float q8[8], q4[4], q2[2], q1;
                    { const bool hi = (lane & 32) != 0;
#pragma unroll
                      for (int i = 0; i < 8; ++i) { const float send = hi ? p[i] : p[i + 8], keep = hi ? p[i + 8] : p[i]; q8[i] = keep + __shfl_xor(send, 32); } }
                    { const bool hi = (lane & 16) != 0;
#pragma unroll
                      for (int i = 0; i < 4; ++i) { const float send = hi ? q8[i] : q8[i + 4], keep = hi ? q8[i + 4] : q8[i]; q4[i] = keep + __shfl_xor(send, 16); } }
                    { const bool hi = (lane & 8) != 0;
#pragma unroll
                      for (int i = 0; i < 2; ++i) { const float send = hi ? q4[i] : q4[i + 2], keep = hi ? q4[i + 2] : q4[i]; q2[i] = keep + __shfl_xor(send, 8); } }
                    { const bool hi = (lane & 4) != 0; const float send = hi ? q2[0] : q2[1], keep = hi ? q2[1] : q2[0]; q1 = keep + __shfl_xor(send, 4); }
                    q1 += __shfl_xor(q1, 2); q1 += __shfl_xor(q1, 1);
                    if ((lane & 3) == 0) { const int g = lane >> 2; const float pre = q1 + b_if[g]; const float cp = GATE_CAP * tanhf(pre * (1.0f / GATE_CAP));
                        gates[row * 16 + g] = (g < 8) ? cp : -log1pf(expf(-cp)); }
                }
            }
        }
    }
    if (GATES) __syncthreads();
#undef NRN_LDX
}
constexpr int ML_QS = 0, ML_KS = 18432, ML_VS = 36864, ML_SS = 75776, ML_CT = 110592, ML_G = 131328;
constexpr int ML_SPLIT = 9;
constexpr int ML_QSTR = 144, ML_VSTR = 304, ML_SSTR = 272, ML_CSTR = 144;
static_assert(ML_G + 4 * 512 + 64 <= LDSCTL_OFF, "mLSTM LDS images fit below the control words");
__device__ __forceinline__ void mlstm_unit(Frame& F, int b, int h, int c_begin, int c_full, int c_end, const bf16* P, const float* gates, const float* hng, bf16* HH) {
    const int tid = F.tid, lane = F.lane, w = F.wave, c16 = lane & 15, q = lane >> 4;
    LAS unsigned char* Qs = F.lds + ML_QS; LAS unsigned char* Ks = F.lds + ML_KS; LAS unsigned char* Vs = F.lds + ML_VS;
    LAS unsigned char* Ssw = F.lds + ML_SS + w * (16 * ML_SSTR); LAS unsigned char* Cts = F.lds + ML_CT;
    LAS float* g_bc = (LAS float*)(F.lds + ML_G); LAS float* g_ii = g_bc + 128; LAS float* g_w = g_bc + 256; LAS float* g_eb = g_bc + 384; LAS float* g_tot = g_bc + 512;
    for (int i = tid; i < 144 * ML_CSTR / 4; i += NWAVES * 64) ((LAS unsigned*)Cts)[i] = 0u;
    for (int i = tid; i < 128 * 12; i += NWAVES * 64) { const int l = i / 12, cpair = i % 12; ((LAS unsigned*)(Vs + l * ML_VSTR + 256))[cpair] = (cpair == 0) ? 0x00003F80u : 0u; }
    const int dt = w & 3, eh = w >> 2;
    f32x4 st[5];
#pragma unroll
    for (int k = 0; k < 5; ++k) st[k] = (f32x4){0.f, 0.f, 0.f, 0.f};
    const int irow = 16 * w + c16;
    v4u qreg[2], kreg[2], vreg[4]; v2u onx[8]; float lf_own = 0.f, lf_oth = 0.f, ii_own = 0.f;
#define ML_PREFETCH(cc, wantq) do { const size_t r0_ = (size_t)b * SEQ + (size_t)(cc) * CH; \
        _Pragma("unroll") for (int i = 0; i < 2; ++i) { const int ci = tid + 512 * i, l = ci >> 3, ch = ci & 7; const bf16* src = P + (r0_ + l) * AQ + h * DK + ch * 8; if (wantq) qreg[i] = *(const v4u*)src; kreg[i] = *(const v4u*)(src + 512); } \
        _Pragma("unroll") for (int i = 0; i < 4; ++i) { const int ci = tid + 512 * i, l = ci >> 4, ch = ci & 15; vreg[i] = *(const v4u*)(P + (r0_ + l) * AQ + 1024 + h * DV + ch * 8); } \
        if (wantq) { _Pragma("unroll") for (int et = 0; et < 8; ++et) onx[et] = *(const v2u*)(P + (r0_ + irow) * AQ + 2048 + h * DV + 16 * et + 4 * q); } \
        if (w < 2) { const int t_ = 64 * w + lane, o_ = 64 * (1 - w) + lane; ii_own = gates[(r0_ + t_) * 16 + h]; lf_own = gates[(r0_ + t_) * 16 + 8 + h]; lf_oth = gates[(r0_ + o_) * 16 + 8 + h]; } } while (0)
    ML_PREFETCH(c_begin, c_begin >= c_full);
    __syncthreads();
    for (int c = c_begin; c < c_end; ++c) {
        const bool full = c >= c_full;
        const size_t r0 = (size_t)b * SEQ + (size_t)c * CH;
        if (w < 2) { float x = lf_own;
#pragma unroll
            for (int o = 1; o < 64; o <<= 1) { const float y = __shfl_up(x, o); if (lane >= o) x += y; }
            const float tot_own = __shfl(x, 63), tot_oth = wave_sum(lf_oth);
            const float blast_ = tot_own + tot_oth, bc = x + (w == 1 ? tot_oth : 0.f);
            const int t = 64 * w + lane;
            g_bc[t] = bc; g_ii[t] = ii_own; g_w[t] = expf(blast_ - bc + ii_own); g_eb[t] = expf(bc);
            if (tid == 0) g_tot[0] = blast_; }
#pragma unroll
        for (int i = 0; i < 2; ++i) { const int ci = tid + 512 * i, l = ci >> 3, ch = ci & 7; if (full) *(LAS v4u*)(Qs + l * ML_QSTR + ch * 16) = qreg[i]; *(LAS v4u*)(Ks + l * ML_QSTR + ch * 16) = kreg[i]; }
#pragma unroll
        for (int i = 0; i < 4; ++i) { const int ci = tid + 512 * i, l = ci >> 4, ch = ci & 15; *(LAS v4u*)(Vs + l * ML_VSTR + ch * 16) = vreg[i]; }
        v2u ocur[8];
#pragma unroll
        for (int et = 0; et < 8; ++et) ocur[et] = onx[et];
        if (c + 1 < c_end) { const bool nfull = (c + 1) >= c_full; ML_PREFETCH(c + 1, nfull); }
        __syncthreads();
        const float blast = g_tot[0];
        if (full) {
            const float bci = g_bc[irow];
            bf16x8 qf[2]; qf[0] = frag_kc(Qs, irow, 8 * q, ML_QSTR); qf[1] = frag_kc(Qs, irow, 32 + 8 * q, ML_QSTR);
            for (int jt = 0; jt <= w; ++jt) {
                f32x4 s = (f32x4){0.f, 0.f, 0.f, 0.f};
#pragma unroll
                for (int kk = 0; kk < 2; ++kk) { const bf16x8 kf = frag_kc(Ks, 16 * jt + c16, 32 * kk + 8 * q, ML_QSTR); s = MFMA16(kf, qf[kk], s); }
                const f32x4 bcj = *(const LAS f32x4*)(g_bc + 16 * jt + 4 * q), iij = *(const LAS f32x4*)(g_ii + 16 * jt + 4 * q);
#pragma unroll
                for (int r = 0; r < 4; ++r) { const int j = 16 * jt + 4 * q + r; const float d = (j <= irow) ? expf(bci - bcj[r] + iij[r]) : 0.f; s[r] = (j <= irow) ? s[r] * d : 0.f; }
                v2u pw; pw.x = pk2(s[0], s[1]); pw.y = pk2(s[2], s[3]);
                *(LAS v2u*)(Ssw + c16 * ML_SSTR + (16 * jt + 4 * q) * 2) = pw;
            }
            if ((w & 1) == 0) *(LAS v2u*)(Ssw + c16 * ML_SSTR + (16 * (w + 1) + 4 * q) * 2) = (v2u){0u, 0u};
            f32x4 acc[9];
#pragma unroll
            for (int et = 0; et < 9; ++et) { f32x4 a = (f32x4){0.f, 0.f, 0.f, 0.f};
#pragma unroll
                for (int kk = 0; kk < 2; ++kk) { const bf16x8 cf = frag_kc(Cts, 16 * et + c16, 32 * kk + 8 * q, ML_CSTR); a = MFMA16(cf, qf[kk], a); }
                acc[et] = a; }
            { const float ebi = g_eb[irow];
#pragma unroll
              for (int et = 0; et < 9; ++et) acc[et] = acc[et] * ebi; }
            const int nks = (w + 2) >> 1;
            for (int ks = 0; ks < nks; ++ks) {
                const bf16x8 sf = frag_kc(Ssw, c16, 32 * ks + 8 * q, ML_SSTR);
#pragma unroll
                for (int et = 0; et < 9; ++et) { const bf16x8 vf = frag_tr(Vs, 32 * ks, 16 * et, ML_VSTR, lane); acc[et] = MFMA16(vf, sf, acc[et]); }
            }
            { const float den = __shfl(acc[8][0], c16);
              const float inv = 1.0f / fmaxf(fabsf(den), 1.0f);
              float ss = 0.f;
#pragma unroll
              for (int et = 0; et < 8; ++et) { acc[et] = acc[et] * inv; ss += (acc[et][0] * acc[et][0] + acc[et][1] * acc[et][1]) + (acc[et][2] * acc[et][2] + acc[et][3] * acc[et][3]); }
              ss += __shfl_xor(ss, 16); ss += __shfl_xor(ss, 32);
              const float rn = 1.0f / sqrtf(ss * (1.0f / DV) + EPS);
              const size_t row = r0 + irow;
#pragma unroll
              for (int et = 0; et < 8; ++et) { const int e0 = 16 * et + 4 * q;
                  const v2u ow = ocur[et];
                  const f32x4 gv = *(const f32x4*)(hng + h * DV + e0);
                  const float o0 = bflo(ow.x), o1 = bfhi(ow.x), o2 = bflo(ow.y), o3 = bfhi(ow.y);
                  const float y0 = acc[et][0] * rn * gv[0] / (1.0f + __expf(-o0)), y1 = acc[et][1] * rn * gv[1] / (1.0f + __expf(-o1));
                  const float y2 = acc[et][2] * rn * gv[2] / (1.0f + __expf(-o2)), y3 = acc[et][3] * rn * gv[3] / (1.0f + __expf(-o3));
                  v2u pw; pw.x = pk2(y0, y1); pw.y = pk2(y2, y3);
                  *(v2u*)(HH + row * D + h * DV + e0) = pw; } }
        }
        { const float dec = expf(blast);
#pragma unroll
          for (int k = 0; k < 5; ++k) st[k] = st[k] * dec;
#pragma unroll
          for (int ks = 0; ks < 4; ++ks) {
              bf16x8 kf = frag_tr(Ks, 32 * ks, 16 * dt, ML_QSTR, lane);
              const f32x4 w0 = *(const LAS f32x4*)(g_w + 32 * ks + 8 * q), w1 = *(const LAS f32x4*)(g_w + 32 * ks + 8 * q + 4);
              { const unsigned a0 = pk2(bf2f((unsigned short)kf[0]) * w0[0], bf2f((unsigned short)kf[1]) * w0[1]), a1 = pk2(bf2f((unsigned short)kf[2]) * w0[2], bf2f((unsigned short)kf[3]) * w0[3]);
                const unsigned a2 = pk2(bf2f((unsigned short)kf[4]) * w1[0], bf2f((unsigned short)kf[5]) * w1[1]), a3 = pk2(bf2f((unsigned short)kf[6]) * w1[2], bf2f((unsigned short)kf[7]) * w1[3]);
                kf = __builtin_bit_cast(bf16x8, (v4u){a0, a1, a2, a3}); }
#pragma unroll
              for (int k = 0; k < 5; ++k) { const int et = eh + 2 * k; if (et < 9) { const bf16x8 vf = frag_tr(Vs, 32 * ks, 16 * et, ML_VSTR, lane); st[k] = MFMA16(kf, vf, st[k]); } }
          } }
        __syncthreads();
#pragma unroll
        for (int k = 0; k < 5; ++k) { const int et = eh + 2 * k; if (et < 9) { v2u pw; pw.x = pk2(st[k][0], st[k][1]); pw.y = pk2(st[k][2], st[k][3]);
            *(LAS v2u*)(Cts + (16 * et + c16) * ML_CSTR + (16 * dt + 4 * q) * 2) = pw; } }
    }
    __syncthreads();
#undef ML_PREFETCH
}

constexpr int SG_AS = 0, SG_VS = 34816, SG_F = 69632;
constexpr int SG_STR = 272;
__device__ __forceinline__ void sgu_unit(Frame& F, int b, int n, int g, bf16* Z, const f32x2* stats, const float* wsg  , const float* bsg  , const float* lng, const float* lnb  ) {
    const int tid = F.tid, lane = F.lane, w = F.wave, c16 = lane & 15, q = lane >> 4;
    LAS unsigned char* As = F.lds + SG_AS; LAS unsigned char* Vs = F.lds + SG_VS;
    LAS float* f_mu = (LAS float*)(F.lds + SG_F); LAS float* f_rs = f_mu + 128; LAS float* f_r1 = f_mu + 256; LAS float* f_r2 = f_mu + 384;
    const size_t r0 = (size_t)b * SEQ + (size_t)n * CH;
    v4u vreg[4];
#pragma unroll
    for (int i = 0; i < 4; ++i) { const int ci = tid + 512 * i, l = ci >> 4, ch = ci & 15; vreg[i] = *(const v4u*)(Z + (r0 + l) * GFFN + GHALF + g * 128 + ch * 8); }
    if (tid < 128) { const f32x4* sp = (const f32x4*)(stats + (r0 + tid) * 32); float s = 0.f, s2 = 0.f;
#pragma unroll
        for (int i = 0; i < 16; ++i) { const f32x4 v = sp[i]; s += v[0] + v[2]; s2 += v[1] + v[3]; }
        const float mu = s * (1.0f / GHALF), var = fmaxf(s2 * (1.0f / GHALF) - mu * mu, 0.f);
        f_mu[tid] = mu; f_rs[tid] = 1.0f / sqrtf(var + EPS); }
#pragma unroll
    for (int i = 0; i < 4; ++i) { const int ci = tid + 512 * i, l = ci >> 4, ch = ci & 15; *(LAS v4u*)(Vs + l * SG_STR + ch * 16) = vreg[i]; }
    __syncthreads();
#pragma unroll
    for (int i = 0; i < 4; ++i) { const int ci = tid + 512 * i, t = ci >> 4, s0 = (ci & 15) * 8; float r1 = 0.f, r2 = 0.f; unsigned pw[4] = {0u, 0u, 0u, 0u};
        if (s0 <= t) { const f32x4 a = *(const f32x4*)(wsg + t * 128 + s0), c = *(const f32x4*)(wsg + t * 128 + s0 + 4);
            const f32x4 ra = *(const LAS f32x4*)(f_rs + s0), rc = *(const LAS f32x4*)(f_rs + s0 + 4), ma = *(const LAS f32x4*)(f_mu + s0), mc = *(const LAS f32x4*)(f_mu + s0 + 4);
            float e[8];
#pragma unroll
            for (int k = 0; k < 4; ++k) { const float wa = (s0 + k <= t) ? a[k] : 0.f, wc = (s0 + 4 + k <= t) ? c[k] : 0.f; r2 += wa + wc; e[k] = wa * ra[k]; e[4 + k] = wc * rc[k]; }
#pragma unroll
            for (int k = 0; k < 4; ++k) pw[k] = pk2(e[2 * k], e[2 * k + 1]);
#pragma unroll
            for (int k = 0; k < 4; ++k) { r1 += bflo(pw[k]) * ((2 * k < 4) ? ma[2 * k] : mc[2 * k - 4]) + bfhi(pw[k]) * ((2 * k + 1 < 4) ? ma[2 * k + 1] : mc[2 * k + 1 - 4]); } }
        *(LAS v4u*)(As + t * SG_STR + s0 * 2) = (v4u){pw[0], pw[1], pw[2], pw[3]};
        r1 += __shfl_xor(r1, 1); r1 += __shfl_xor(r1, 2); r1 += __shfl_xor(r1, 4); r1 += __shfl_xor(r1, 8);
        r2 += __shfl_xor(r2, 1); r2 += __shfl_xor(r2, 2); r2 += __shfl_xor(r2, 4); r2 += __shfl_xor(r2, 8);
        if ((ci & 15) == 0) { f_r1[t] = r1; f_r2[t] = r2; } }
    __syncthreads();
    f32x4 acc[8];
#pragma unroll
    for (int ct = 0; ct < 8; ++ct) acc[ct] = (f32x4){0.f, 0.f, 0.f, 0.f};
    const int trow = 16 * w + c16, nks = (w + 2) >> 1;
    for (int ks = 0; ks < nks; ++ks) {
        const bf16x8 af = frag_kc(As, trow, 32 * ks + 8 * q, SG_STR);
#pragma unroll
        for (int ct = 0; ct < 8; ++ct) { const bf16x8 vf = frag_tr(Vs, 32 * ks, 16 * ct, SG_STR, lane); acc[ct] = MFMA16(vf, af, acc[ct]); }
    }
    { const float r1 = f_r1[trow], r2 = f_r2[trow], bsv = bsg[trow]; bf16* urow = Z + (r0 + trow) * GFFN + g * 128;
#pragma unroll
      for (int ct = 0; ct < 8; ++ct) { const int c0 = 16 * ct + 4 * q; const f32x4 lg = *(const f32x4*)(lng + g * 128 + c0), lb = *(const f32x4*)(lnb + g * 128 + c0);
          const v2u uw = *(const v2u*)(urow + c0);
          const float y0 = bflo(uw.x) * (lg[0] * (acc[ct][0] - r1) + lb[0] * r2 + bsv), y1 = bfhi(uw.x) * (lg[1] * (acc[ct][1] - r1) + lb[1] * r2 + bsv);
          const float y2 = bflo(uw.y) * (lg[2] * (acc[ct][2] - r1) + lb[2] * r2 + bsv), y3 = bfhi(uw.y) * (lg[3] * (acc[ct][3] - r1) + lb[3] * r2 + bsv);
          v2u pw; pw.x = pk2(y0, y1); pw.y = pk2(y2, y3); *(v2u*)(urow + c0) = pw; } }
    __syncthreads();
}
struct Args { const float* in[18]; float* out; unsigned char* ws; int ph_lo, ph_hi; };
constexpr int NPHASE = 2 + 2 * 14;
#ifndef PG8_SP2
#define PG8_SP2 true
#endif
#ifndef PG8_ALIGN
#define PG8_ALIGN true
#endif
#if defined(PROBE_P0)
#define REP_P0(...) __VA_ARGS__ __VA_ARGS__
#else
#define REP_P0(...) __VA_ARGS__
#endif
#if defined(PROBE_PH1)
#define REP_PH1(...) __VA_ARGS__ __VA_ARGS__
#else
#define REP_PH1(...) __VA_ARGS__
#endif
#if defined(PROBE_ML)
#define REP_ML(...) __VA_ARGS__ __VA_ARGS__
#else
#define REP_ML(...) __VA_ARGS__
#endif
#if defined(PROBE_FFN1)
#define REP_FFN1(...) __VA_ARGS__ __VA_ARGS__
#else
#define REP_FFN1(...) __VA_ARGS__
#endif
#if defined(PROBE_FFN2)
#define REP_FFN2(...) __VA_ARGS__ __VA_ARGS__
#else
#define REP_FFN2(...) __VA_ARGS__
#endif
#if defined(PROBE_AIN)
#define REP_AIN(...) __VA_ARGS__ __VA_ARGS__
#else
#define REP_AIN(...) __VA_ARGS__
#endif
#if defined(PROBE_N1K)
#define REP_N1K(...) __VA_ARGS__ __VA_ARGS__
#else
#define REP_N1K(...) __VA_ARGS__
#endif
#if defined(PROBE_SGIN)
#define REP_SGIN(...) __VA_ARGS__ __VA_ARGS__
#else
#define REP_SGIN(...) __VA_ARGS__
#endif
#if defined(PROBE_SGOUT)
#define REP_SGOUT(...) __VA_ARGS__ __VA_ARGS__
#else
#define REP_SGOUT(...) __VA_ARGS__
#endif
__global__ void __launch_bounds__(NWAVES * 64, 2) trunk_fwd(Args args) {
    extern __shared__ __attribute__((aligned(16))) unsigned char lds[];
    Frame F;
    F.lds = (LAS unsigned char*)lds;
    F.MISC = (volatile LAS unsigned*)(F.lds + MISC_OFF);
    F.tid = threadIdx.x; F.lane = F.tid & 63; F.wave = __builtin_amdgcn_readfirstlane(F.tid >> 6);
    F.G = gridDim.x; { const int bx = blockIdx.x; F.vcu = (F.G % 8 == 0) ? (bx % 8) * (F.G / 8) + bx / 8 : bx; }
    unsigned char* const ws = args.ws;
    F.ctl = (gu32*)(ws + WS_CTL);
    float* const OUT = args.out;
    for (int u = F.tid; u < (LDS_BYTES - LDSCTL_OFF) / 4; u += NWAVES * 64) ((LAS unsigned*)(F.lds + LDSCTL_OFF))[u] = 0u;
    __syncthreads();
    XcdBarrier bar; bar.bar = (unsigned*)(F.ctl + CW_BAR); bar.x = 0; bar.st = nullptr;
    const bool one_launch = (args.ph_hi - args.ph_lo) > 1;
    if (one_launch) bar = xcd_barrier_post((unsigned*)(F.ctl + CW_BAR), F.MISC + 8);
    const int lo = args.ph_lo, hi = args.ph_hi;
#define ZDEF int z_; asm volatile("s_mov_b32 %0, 0" : "=s"(z_))
#define INP(k) ((const float*)(const GAS float*)args.in[(k) + z_])
#define WSF(off) ((float*)(ws + (size_t)(off) + z_))
#define WSB(off) ((bf16*)(ws + (size_t)(off) + z_))
#define IN(k) (lo <= (k) && (k) < hi)
#define SEAM(k) do { if (IN(k) && IN((k) + 1)) { XcdBarrier b_ = bar; asm volatile("" : "+s"(b_.bar), "+s"(b_.x)); xcd_barrier(b_); } } while (0)
#define GEMM_PHASE(EPI, Aptr, LDA, Bptr, NN, KK, ...) do { pg8::Gemm g_{(const pg8::bf16_t*)(Aptr), (const pg8::bf16_t*)(Bptr), M, (NN), (KK), (LDA)}; pg8::StaticOrder S_; S_.init(M, (NN), F.G, (int)blockIdx.x); \
        EPI E_{__VA_ARGS__}; pg8::gemm_phase<EPI, pg8::StaticOrder, PG8_ALIGN, PG8_SP2>(F.lds + RING_OFF, g_, S_, E_); } while (0)
    constexpr size_t MODL = (size_t)NB * 6 * D;

    REP_P0(if (IN(0)) { ZDEF; In I;
        I.x = INP(0); I.c = INP(1); I.norm_g = INP(2); I.ada_w = INP(3); I.ada_b = INP(4); I.ffn_w1 = INP(5); I.ffn_w2 = INP(6); I.a_w_in = INP(7); I.a_b_if = INP(8);
        I.a_hnorm_g = INP(9); I.a_w_out = INP(10); I.b_w_in = INP(11); I.b_b_in = INP(12); I.b_ln_g = INP(13); I.b_ln_b = INP(14); I.b_ws = INP(15); I.b_bs = INP(16); I.b_w_out = INP(17);
        p0_prologue(F, I, ws + z_); })
    SEAM(0);
    REP_PH1(if (IN(1)) { ZDEF; const float* mod = WSF(WS_MOD);
        nrn_phase<false, true, true, true, false>(F, INP(0), nullptr, nullptr, WSB(WS_H), nullptr, nullptr, INP(2) + 0 * D, mod + 1 * D, mod + 0 * D, WSF(WS_GW), INP(8), WSF(WS_GATES)); })
    SEAM(1);
    { constexpr int pr = 0;
        const int pb = 2 + 14 * pr;
        const int la = 2 * pr, lb = 2 * pr + 1;
        REP_AIN(if (IN(pb + 0)) { ZDEF; GEMM_PHASE(pg8::EpiBf16<0>, WSB(WS_H), D, WSB(WS_AWIN) + (size_t)pr * AQ * D, AQ, D, (pg8::bf16_t*)WSB(WS_P), AQ); })
        SEAM(pb + 0);
        REP_ML(if (IN(pb + 1)) { ZDEF; const bf16* Pb = WSB(WS_P); const float* gates = WSF(WS_GATES); const float* hng = INP(9) + pr * D; bf16* Hb = WSB(WS_H);
            for (int u = blockIdx.x; u < 2 * NB * NH; u += F.G) { const int bh = u >> 1, hf = u & 1; mlstm_unit(F, bh >> 3, bh & 7, 0, hf ? ML_SPLIT : 0, hf ? NCH : ML_SPLIT, Pb, gates, hng, Hb); } })
        SEAM(pb + 1);
        REP_N1K(if (IN(pb + 2)) { ZDEF; GEMM_PHASE(pg8::EpiBf16<0>, WSB(WS_H), D, WSB(WS_AWOUT) + (size_t)pr * D * D, D, D, (pg8::bf16_t*)WSB(WS_P), D); })
        SEAM(pb + 2);
        if (IN(pb + 3)) { ZDEF; const float* ma = WSF(WS_MOD) + la * MODL; const float* ng = INP(2) + la * 4 * D; if (pr == 0) nrn_phase<true, true, false, true, false>(F, INP(0), WSB(WS_X), WSB(WS_P), WSB(WS_H), ng + 1 * D, ma + 2 * D, ng + 2 * D, ma + 4 * D, ma + 3 * D, nullptr, nullptr, nullptr);
            else nrn_phase<true, true, false, false, false>(F, WSB(WS_X), WSB(WS_X), WSB(WS_P), WSB(WS_H), ng + 1 * D, ma + 2 * D, ng + 2 * D, ma + 4 * D, ma + 3 * D, nullptr, nullptr, nullptr); }
        SEAM(pb + 3);
        REP_FFN1(if (IN(pb + 4)) { ZDEF; GEMM_PHASE(pg8::EpiBf16<2>, WSB(WS_H), D, WSB(WS_W1T) + (size_t)la * D * FF, FF, D, (pg8::bf16_t*)WSB(WS_P), FF); })
        SEAM(pb + 4);
        REP_FFN2(if (IN(pb + 5)) { ZDEF; GEMM_PHASE(pg8::EpiBf16<0>, WSB(WS_P), FF, WSB(WS_W2T) + (size_t)la * D * FF, D, FF, (pg8::bf16_t*)WSB(WS_H), D); })
        SEAM(pb + 5);
        if (IN(pb + 6)) { ZDEF; const float* ma = WSF(WS_MOD) + la * MODL; const float* mb = WSF(WS_MOD) + lb * MODL; const float* ng = INP(2) + la * 4 * D;
            nrn_phase<true, true, false, false, false>(F, WSB(WS_X), WSB(WS_X), WSB(WS_H), WSB(WS_H), ng + 3 * D, ma + 5 * D, ng + 4 * D, mb + 1 * D, mb + 0 * D, nullptr, nullptr, nullptr); }
        SEAM(pb + 6);
        REP_SGIN(if (IN(pb + 7)) { ZDEF; GEMM_PHASE(pg8::EpiGeluStats, WSB(WS_H), D, WSB(WS_BWIN) + (size_t)pr * D * GFFN, GFFN, D, (pg8::bf16_t*)WSB(WS_P), GFFN, INP(12) + pr * GFFN, (pg8::f32x2*)WSF(WS_STATS)); })
        SEAM(pb + 7);
        if (IN(pb + 8)) { ZDEF; bf16* Pb = WSB(WS_P); const f32x2* stats = (const f32x2*)WSF(WS_STATS); const float* wsl = INP(15) + (size_t)pr * NGRP * CH * CH; const float* bsl = INP(16) + pr * NGRP * CH;
            const float* lng = INP(13) + pr * GHALF; const float* lnb = INP(14) + pr * GHALF;
            for (int u = F.vcu; u < NB * NCH * NGRP; u += F.G) { const int g = u & 15, n = (u >> 4) & 15, b = u >> 8; sgu_unit(F, b, n, g, Pb, stats, wsl + (size_t)g * CH * CH, bsl + g * CH, lng, lnb); } }
        SEAM(pb + 8);
        REP_SGOUT(if (IN(pb + 9)) { ZDEF; GEMM_PHASE(pg8::EpiBf16<0>, WSB(WS_P), GFFN, WSB(WS_BWOUT) + (size_t)pr * GHALF * D, D, GHALF, (pg8::bf16_t*)WSB(WS_H), D); })
        SEAM(pb + 9);
        if (IN(pb + 10)) { ZDEF; const float* mb = WSF(WS_MOD) + lb * MODL; const float* ng = INP(2) + lb * 4 * D;
            nrn_phase<true, true, false, false, false>(F, WSB(WS_X), WSB(WS_X), WSB(WS_H), WSB(WS_H), ng + 1 * D, mb + 2 * D, ng + 2 * D, mb + 4 * D, mb + 3 * D, nullptr, nullptr, nullptr); }
        SEAM(pb + 10);
        REP_FFN1(if (IN(pb + 11)) { ZDEF; GEMM_PHASE(pg8::EpiBf16<2>, WSB(WS_H), D, WSB(WS_W1T) + (size_t)lb * D * FF, FF, D, (pg8::bf16_t*)WSB(WS_P), FF); })
        SEAM(pb + 11);
        REP_FFN2(if (IN(pb + 12)) { ZDEF; GEMM_PHASE(pg8::EpiBf16<0>, WSB(WS_P), FF, WSB(WS_W2T) + (size_t)lb * D * FF, D, FF, (pg8::bf16_t*)WSB(WS_H), D); })
        SEAM(pb + 12);
        if (IN(pb + 13)) { ZDEF; const float* mb = WSF(WS_MOD) + lb * MODL; const float* ng = INP(2) + lb * 4 * D;
            if (pr == 0) { const float* mn = mb + MODL;
                nrn_phase<true, true, true, false, false>(F, WSB(WS_X), WSB(WS_X), WSB(WS_H), WSB(WS_H), ng + 3 * D, mb + 5 * D, ng + 4 * D, mn + 1 * D, mn + 0 * D, WSF(WS_GW) + 16 * D, INP(8) + 16, WSF(WS_GATES)); }
            else nrn_phase<true, false, false, false, true>(F, WSB(WS_X), OUT, WSB(WS_H), nullptr, ng + 3 * D, mb + 5 * D, nullptr, nullptr, nullptr, nullptr, nullptr, nullptr); }
        SEAM(pb + 13);
        }
    { constexpr int pr = 1;
        const int pb = 2 + 14 * pr;
        const int la = 2 * pr, lb = 2 * pr + 1;
        REP_AIN(if (IN(pb + 0)) { ZDEF; GEMM_PHASE(pg8::EpiBf16<0>, WSB(WS_H), D, WSB(WS_AWIN) + (size_t)pr * AQ * D, AQ, D, (pg8::bf16_t*)WSB(WS_P), AQ); })
        SEAM(pb + 0);
        REP_ML(if (IN(pb + 1)) { ZDEF; const bf16* Pb = WSB(WS_P); const float* gates = WSF(WS_GATES); const float* hng = INP(9) + pr * D; bf16* Hb = WSB(WS_H);
            for (int u = blockIdx.x; u < 2 * NB * NH; u += F.G) { const int bh = u >> 1, hf = u & 1; mlstm_unit(F, bh >> 3, bh & 7, 0, hf ? ML_SPLIT : 0, hf ? NCH : ML_SPLIT, Pb, gates, hng, Hb); } })
        SEAM(pb + 1);
        REP_N1K(if (IN(pb + 2)) { ZDEF; GEMM_PHASE(pg8::EpiBf16<0>, WSB(WS_H), D, WSB(WS_AWOUT) + (size_t)pr * D * D, D, D, (pg8::bf16_t*)WSB(WS_P), D); })
        SEAM(pb + 2);
        if (IN(pb + 3)) { ZDEF; const float* ma = WSF(WS_MOD) + la * MODL; const float* ng = INP(2) + la * 4 * D; if (pr == 0) nrn_phase<true, true, false, true, false>(F, INP(0), WSB(WS_X), WSB(WS_P), WSB(WS_H), ng + 1 * D, ma + 2 * D, ng + 2 * D, ma + 4 * D, ma + 3 * D, nullptr, nullptr, nullptr);
            else nrn_phase<true, true, false, false, false>(F, WSB(WS_X), WSB(WS_X), WSB(WS_P), WSB(WS_H), ng + 1 * D, ma + 2 * D, ng + 2 * D, ma + 4 * D, ma + 3 * D, nullptr, nullptr, nullptr); }
        SEAM(pb + 3);
        REP_FFN1(if (IN(pb + 4)) { ZDEF; GEMM_PHASE(pg8::EpiBf16<2>, WSB(WS_H), D, WSB(WS_W1T) + (size_t)la * D * FF, FF, D, (pg8::bf16_t*)WSB(WS_P), FF); })
        SEAM(pb + 4);
        REP_FFN2(if (IN(pb + 5)) { ZDEF; GEMM_PHASE(pg8::EpiBf16<0>, WSB(WS_P), FF, WSB(WS_W2T) + (size_t)la * D * FF, D, FF, (pg8::bf16_t*)WSB(WS_H), D); })
        SEAM(pb + 5);
        if (IN(pb + 6)) { ZDEF; const float* ma = WSF(WS_MOD) + la * MODL; const float* mb = WSF(WS_MOD) + lb * MODL; const float* ng = INP(2) + la * 4 * D;
            nrn_phase<true, true, false, false, false>(F, WSB(WS_X), WSB(WS_X), WSB(WS_H), WSB(WS_H), ng + 3 * D, ma + 5 * D, ng + 4 * D, mb + 1 * D, mb + 0 * D, nullptr, nullptr, nullptr); }
        SEAM(pb + 6);
        REP_SGIN(if (IN(pb + 7)) { ZDEF; GEMM_PHASE(pg8::EpiGeluStats, WSB(WS_H), D, WSB(WS_BWIN) + (size_t)pr * D * GFFN, GFFN, D, (pg8::bf16_t*)WSB(WS_P), GFFN, INP(12) + pr * GFFN, (pg8::f32x2*)WSF(WS_STATS)); })
        SEAM(pb + 7);
        if (IN(pb + 8)) { ZDEF; bf16* Pb = WSB(WS_P); const f32x2* stats = (const f32x2*)WSF(WS_STATS); const float* wsl = INP(15) + (size_t)pr * NGRP * CH * CH; const float* bsl = INP(16) + pr * NGRP * CH;
            const float* lng = INP(13) + pr * GHALF; const float* lnb = INP(14) + pr * GHALF;
            for (int u = F.vcu; u < NB * NCH * NGRP; u += F.G) { const int g = u & 15, n = (u >> 4) & 15, b = u >> 8; sgu_unit(F, b, n, g, Pb, stats, wsl + (size_t)g * CH * CH, bsl + g * CH, lng, lnb); } }
        SEAM(pb + 8);
        REP_SGOUT(if (IN(pb + 9)) { ZDEF; GEMM_PHASE(pg8::EpiBf16<0>, WSB(WS_P), GFFN, WSB(WS_BWOUT) + (size_t)pr * GHALF * D, D, GHALF, (pg8::bf16_t*)WSB(WS_H), D); })
        SEAM(pb + 9);
        if (IN(pb + 10)) { ZDEF; const float* mb = WSF(WS_MOD) + lb * MODL; const float* ng = INP(2) + lb * 4 * D;
            nrn_phase<true, true, false, false, false>(F, WSB(WS_X), WSB(WS_X), WSB(WS_H), WSB(WS_H), ng + 1 * D, mb + 2 * D, ng + 2 * D, mb + 4 * D, mb + 3 * D, nullptr, nullptr, nullptr); }
        SEAM(pb + 10);
        REP_FFN1(if (IN(pb + 11)) { ZDEF; GEMM_PHASE(pg8::EpiBf16<2>, WSB(WS_H), D, WSB(WS_W1T) + (size_t)lb * D * FF, FF, D, (pg8::bf16_t*)WSB(WS_P), FF); })
        SEAM(pb + 11);
        REP_FFN2(if (IN(pb + 12)) { ZDEF; GEMM_PHASE(pg8::EpiBf16<0>, WSB(WS_P), FF, WSB(WS_W2T) + (size_t)lb * D * FF, D, FF, (pg8::bf16_t*)WSB(WS_H), D); })
        SEAM(pb + 12);
        if (IN(pb + 13)) { ZDEF; const float* mb = WSF(WS_MOD) + lb * MODL; const float* ng = INP(2) + lb * 4 * D;
            if (pr == 0) { const float* mn = mb + MODL;
                nrn_phase<true, true, true, false, false>(F, WSB(WS_X), WSB(WS_X), WSB(WS_H), WSB(WS_H), ng + 3 * D, mb + 5 * D, ng + 4 * D, mn + 1 * D, mn + 0 * D, WSF(WS_GW) + 16 * D, INP(8) + 16, WSF(WS_GATES)); }
            else nrn_phase<true, false, false, false, true>(F, WSB(WS_X), OUT, WSB(WS_H), nullptr, ng + 3 * D, mb + 5 * D, nullptr, nullptr, nullptr, nullptr, nullptr, nullptr); }
        SEAM(pb + 13);
        }
#undef ZDEF
#undef INP
#undef WSF
#undef WSB
#undef IN
#undef SEAM
#undef GEMM_PHASE
}

extern "C" void kernel_launch(void* const* d_in, const int* in_sizes, int n_in, void* d_out, int out_size, void* d_ws, size_t ws_size, hipStream_t stream) {
    static int grid = 0;
    if (grid == 0) {
        if (n_in != 18 || in_sizes[0] != M * D || out_size != M * D || ws_size < WS_END) { fprintf(stderr, "kernel_launch: unexpected shapes (n_in %d, in0 %d, out %d, ws %zu); nothing launched\n", n_in, n_in > 0 ? in_sizes[0] : -1, out_size, ws_size); grid = -1; return; }
        int dev = 0, cus = 0, per_cu = 0;
        if (hipGetDevice(&dev) != hipSuccess || hipDeviceGetAttribute(&cus, hipDeviceAttributeMultiprocessorCount, dev) != hipSuccess) { grid = -1; return; }
        if (hipFuncSetAttribute((const void*)trunk_fwd, hipFuncAttributeMaxDynamicSharedMemorySize, LDS_BYTES) != hipSuccess) { fprintf(stderr, "kernel_launch: hipFuncSetAttribute failed\n"); grid = -1; return; }
        if (hipOccupancyMaxActiveBlocksPerMultiprocessor(&per_cu, (const void*)trunk_fwd, NWAVES * 64, LDS_BYTES) != hipSuccess || per_cu < 1) fprintf(stderr, "kernel_launch: occupancy query reports %d\n", per_cu);
        (void)hipGetLastError();
        grid = cus;
    }
    if (grid < 0) return;
    if (hipMemsetAsync((char*)d_ws + WS_CTL, 0, CTL_ZERO_BYTES, stream) != hipSuccess) return;
    Args a{};
    for (int i = 0; i < 18; ++i) a.in[i] = (const float*)d_in[i];
    a.out = (float*)d_out; a.ws = (unsigned char*)d_ws;
#if MK_N_LAUNCHES == 1
    a.ph_lo = 0; a.ph_hi = NPHASE;
    hipLaunchKernelGGL(trunk_fwd, dim3(grid), dim3(NWAVES * 64), LDS_BYTES, stream, a);
#else
    for (int p = 0; p < NPHASE; ++p) { a.ph_lo = p; a.ph_hi = p + 1; hipLaunchKernelGGL(trunk_fwd, dim3(grid), dim3(NWAVES * 64), LDS_BYTES, stream, a); }
#endif
}
```

```cpp
#include <hip/hip_runtime.h>
#include <cstdio>
#include <cstdint>
namespace pg8 {
#define PG8_LAS __attribute__((address_space(3)))
typedef unsigned short bf16_t;
typedef short bf16x8 __attribute__((ext_vector_type(8)));
typedef float f32x4 __attribute__((ext_vector_type(4)));
typedef unsigned u32x4 __attribute__((ext_vector_type(4)));
constexpr int BM = 256, BK = 64, HALF = 128, HTB = HALF * BK * 2  , STAGE_BYTES = 8 * HTB, NXCD = 8;
#ifndef PG8_POST_EPI_SLACK
#define PG8_POST_EPI_SLACK true
#endif
#ifndef PG8_WGM
#define PG8_WGM 4
#endif
constexpr int WGM = PG8_WGM;

__host__ __device__ __forceinline__ int lds_byte(int r, int c) { const int st = (r >> 4) * 2 + (c >> 5), rr = r & 15, cc = c & 31, ob = rr * 64 + cc * 2; return st * 1024 + (ob ^ (((ob >> 9) & 1) << 5)); }
__host__ __device__ __forceinline__ void stage_rc(int b, int& R, int& C) { const int st = b / 1024, sb = b % 1024, swz = sb ^ (((sb >> 9) & 1) << 5); R = (st >> 1) * 16 + swz / 64; C = (st & 1) * 32 + (swz % 64) / 2; }
__host__ __device__ __forceinline__ int perm32(int rho) { const int n = rho >> 4, i = rho & 15; return 8 * (i >> 2) + 4 * n + (i & 3); }

struct Unit { int pm, pn; };
struct Gemm { const bf16_t* A; const bf16_t* Bt; int M, N, K, lda; };

struct StaticOrder {
    int nM, nN, nwg, G, c;
    __host__ __device__ void init(int M, int N, int G_, int c_) { nM = M / BM; nN = N / BM; nwg = nM * nN; G = G_; c = c_; }
    __host__ __device__ bool next(int i, Unit& u) const {
        const long L = (long)i * G + c; if (L >= nwg) return false;
        int wgid = (int)L; { const int q = nwg / NXCD, r = nwg % NXCD, xcd = wgid % NXCD, off = wgid / NXCD; wgid = (xcd < r ? xcd * (q + 1) : r * (q + 1) + (xcd - r) * q) + off; }
        const int nig = WGM * nN, gid = wgid / nig, fm = gid * WGM, gsz = (nM - fm) < WGM ? (nM - fm) : WGM;
        u.pm = fm + ((wgid % nig) % gsz); u.pn = (wgid % nig) / gsz; return true;
    }
    __device__ __forceinline__ void a_ready(const Unit&) const {}
    __device__ __forceinline__ void done(const Unit&) const {}
};
__device__ __forceinline__ unsigned cvt_pk_bf16(float lo, float hi) { unsigned r; asm volatile("v_cvt_pk_bf16_f32 %0, %1, %2" : "=v"(r) : "v"(lo), "v"(hi)); return r; }
typedef float f32x2 __attribute__((ext_vector_type(2)));
__device__ __forceinline__ f32x2 gelu_pk(f32x2 v) {
    const f32x2 av = __builtin_elementwise_abs(v), d = av * 0.2316418882f + 1.0f;
    f32x2 t; t.x = __builtin_amdgcn_rcpf(d.x); t.y = __builtin_amdgcn_rcpf(d.y);
    f32x2 q = t * 0.5307027145f + (-0.7265760135f); q = q * t + 0.7107068705f; q = q * t + (-0.142248368f); q = q * t + 0.127414796f; q = q * t;
    const f32x2 s = (v * v) * (-0.72134752044f);
    f32x2 e; e.x = __builtin_amdgcn_exp2f(s.x); e.y = __builtin_amdgcn_exp2f(s.y);
    const f32x2 m = v * (q * e), r = v - m;
    f32x2 o; o.x = v.x < 0.f ? m.x : r.x; o.y = v.y < 0.f ? m.y : r.y; return o;
}
#if defined(PG8_NT_STORE)
#define PG8_STORE16(p, v) __builtin_nontemporal_store((v), (u32x4*)(p))
#else
#define PG8_STORE16(p, v) (*(u32x4*)(p) = (v))
#endif
template <int ACT  > struct EpiBf16 {
    static constexpr bool PERM = true, AFTER_DRAIN = false; static constexpr int NSTORES = 16;
    bf16_t* O; int ldc;
    __device__ __forceinline__ void operator()(const f32x4 (&acc)[2][2][4][2], const Unit& u, int wr, int wc, int fr, int fq) const {
        const int row0 = u.pm * BM + wr * 64 + fr, col0 = u.pn * BM + wc * 32 + 8 * fq;
#pragma unroll
        for (int ai = 0; ai < 2; ++ai)
#pragma unroll
            for (int m = 0; m < 4; ++m) { bf16_t* rowp = O + (size_t)(row0 + ai * HALF + m * 16) * ldc + col0;
#pragma unroll
                for (int bj = 0; bj < 2; ++bj) { f32x4 v0 = acc[ai][bj][m][0], v1 = acc[ai][bj][m][1];
                    if (ACT == 2) {
#pragma unroll
                        for (int j = 0; j < 4; ++j) { const float a = fmaxf(v0[j], 0.f), b = fmaxf(v1[j], 0.f); v0[j] = a * a; v1[j] = b * b; } }
                    u32x4 w; w.x = cvt_pk_bf16(v0[0], v0[1]); w.y = cvt_pk_bf16(v0[2], v0[3]); w.z = cvt_pk_bf16(v1[0], v1[1]); w.w = cvt_pk_bf16(v1[2], v1[3]);
                    PG8_STORE16(rowp + bj * HALF, w); } }
    }
};
struct EpiGeluStats {
    static constexpr bool PERM = true, AFTER_DRAIN = false; static constexpr int NSTORES = 16;
    bf16_t* O; int ldc; const float* bias; f32x2* stats;
    __device__ __forceinline__ void operator()(const f32x4 (&acc)[2][2][4][2], const Unit& u, int wr, int wc, int fr, int fq) const {
        const int row0 = u.pm * BM + wr * 64 + fr, col0 = u.pn * BM + wc * 32 + 8 * fq;
        f32x4 bv[2][2];
#pragma unroll
        for (int bj = 0; bj < 2; ++bj)
#pragma unroll
            for (int n = 0; n < 2; ++n) bv[bj][n] = *(const f32x4*)(bias + col0 + bj * HALF + 4 * n);
        const bool vhalf = u.pn >= 8;
#pragma unroll
        for (int ai = 0; ai < 2; ++ai)
#pragma unroll
            for (int m = 0; m < 4; ++m) { const int row = row0 + ai * HALF + m * 16; bf16_t* rowp = O + (size_t)row * ldc + col0; float s = 0.f, s2 = 0.f;
#pragma unroll
                for (int bj = 0; bj < 2; ++bj) { f32x4 v0 = acc[ai][bj][m][0] + bv[bj][0], v1 = acc[ai][bj][m][1] + bv[bj][1];
                    { f32x2 a = gelu_pk((f32x2){v0[0], v0[1]}), b = gelu_pk((f32x2){v0[2], v0[3]}), c = gelu_pk((f32x2){v1[0], v1[1]}), d = gelu_pk((f32x2){v1[2], v1[3]});
                      v0 = (f32x4){a.x, a.y, b.x, b.y}; v1 = (f32x4){c.x, c.y, d.x, d.y}; }
                    s += (v0[0] + v0[1]) + (v0[2] + v0[3]) + (v1[0] + v1[1]) + (v1[2] + v1[3]);
                    s2 += (v0[0] * v0[0] + v0[1] * v0[1]) + (v0[2] * v0[2] + v0[3] * v0[3]) + (v1[0] * v1[0] + v1[1] * v1[1]) + (v1[2] * v1[2] + v1[3] * v1[3]);
                    u32x4 w; w.x = cvt_pk_bf16(v0[0], v0[1]); w.y = cvt_pk_bf16(v0[2], v0[3]); w.z = cvt_pk_bf16(v1[0], v1[1]); w.w = cvt_pk_bf16(v1[2], v1[3]);
                    PG8_STORE16(rowp + bj * HALF, w); }
                if (vhalf) { s += __shfl_xor(s, 16); s += __shfl_xor(s, 32); s2 += __shfl_xor(s2, 16); s2 += __shfl_xor(s2, 32);
                    if (fq == 0) stats[(size_t)row * 32 + (u.pn - 8) * 4 + wc] = (f32x2){s, s2}; } }
    }
};

struct EpiNull {
    static constexpr bool PERM = true, AFTER_DRAIN = false; static constexpr int NSTORES = 16;
    __device__ __forceinline__ void operator()(const f32x4 (&acc)[2][2][4][2], const Unit&, int, int, int, int) const {
#pragma unroll
        for (int ai = 0; ai < 2; ++ai)
#pragma unroll
            for (int bj = 0; bj < 2; ++bj)
#pragma unroll
                for (int m = 0; m < 4; ++m)
#pragma unroll
                    for (int n = 0; n < 2; ++n) asm volatile("" :: "v"(acc[ai][bj][m][n]));
    }
};

template <class Epi, class Sched, bool ALIGN_EPI = false, bool SP2 = false>
__device__ __forceinline__ void gemm_phase(PG8_LAS unsigned char* lds, const Gemm g, const Sched& S, const Epi& E) {
    const int tid = threadIdx.x, wid = __builtin_amdgcn_readfirstlane(tid >> 6), lane = tid & 63, wr = wid >> 2, wc = wid & 3, fr = lane & 15, fq = lane >> 4;
    const int K = g.K, nt = K / BK;
    unsigned voffA[2], voffB[2];
#pragma unroll
    for (int i = 0; i < 2; ++i) { int R, C; stage_rc(tid * 16 + i * 8192, R, C); const int Rb = Epi::PERM ? ((R & ~31) + perm32(R & 31)) : R;
        voffA[i] = (unsigned)(R * g.lda + C) * 2u; voffB[i] = (unsigned)(Rb * K + C) * 2u; }
    const size_t kstep = (size_t)(BK * 2);
    const size_t hstepA = (size_t)HALF * g.lda * 2, hstepB = (size_t)HALF * K * 2;
    const size_t tstepA = 2 * hstepA, tstepB = 2 * hstepB;
    const unsigned ldsw = (unsigned)wid * 1024u;
    const int aoff = lds_byte(wr * 64 + fr, fq * 8), boff = lds_byte(wc * 32 + fr, fq * 8);
#define PG8_SA(b, h) (((b) * 2 + (h)) * HTB)
#define PG8_SB(b, h) ((4 + (b) * 2 + (h)) * HTB)
#define PG8_STAGE(bufoff, gbase, voff) do { _Pragma("unroll") for (int _i = 0; _i < 2; ++_i) \
        __builtin_amdgcn_global_load_lds((const unsigned*)((const char*)(gbase) + (voff)[_i]), (PG8_LAS unsigned*)(lds + (bufoff) + ldsw + _i * 8192), 16, 0, 0); } while (0)
#define PG8_LDA(dst, b, h) do { _Pragma("unroll") for (int m = 0; m < 4; ++m) _Pragma("unroll") for (int k = 0; k < 2; ++k) dst[m][k] = *(const PG8_LAS bf16x8*)(lds + PG8_SA(b, h) + aoff + m * 2048 + k * 1024); } while (0)
#define PG8_LDB(dst, b, h) do { _Pragma("unroll") for (int n = 0; n < 2; ++n) _Pragma("unroll") for (int k = 0; k < 2; ++k) dst[n][k] = *(const PG8_LAS bf16x8*)(lds + PG8_SB(b, h) + boff + n * 2048 + k * 1024); } while (0)
#define PG8_MMA(ai, bj, At, Bt) do { __builtin_amdgcn_s_setprio(1); _Pragma("unroll") for (int m = 0; m < 4; ++m) _Pragma("unroll") for (int n = 0; n < 2; ++n) _Pragma("unroll") for (int k = 0; k < 2; ++k) \
        acc[ai][bj][m][n] = __builtin_amdgcn_mfma_f32_16x16x32_bf16(Bt[n][k], At[m][k], acc[ai][bj][m][n], 0, 0, 0); __builtin_amdgcn_s_setprio(0); } while (0)
#define PG8_WAIT_V(n) asm volatile("s_waitcnt vmcnt(" #n ")" ::: "memory")
#define PG8_WAIT_L(n) asm volatile("s_waitcnt lgkmcnt(" #n ")" ::: "memory")
#define PG8_WAIT_V_SEL(flag) asm volatile("s_cmp_lg_u32 %0, 0\n\ts_cbranch_scc1 .Lpe_a%=\n\ts_waitcnt vmcnt(8)\n\ts_branch .Lpe_b%=\n.Lpe_a%=:\n\ts_waitcnt vmcnt(24)\n.Lpe_b%=:" :: "s"(flag) : "memory", "scc")
#define PG8_BAR __builtin_amdgcn_s_barrier()
#define PG8_SCHED __builtin_amdgcn_sched_barrier(0)
    Unit cur, nxt; int ui = 0;
    if (!S.next(0, cur)) return;
    f32x4 acc[2][2][4][2];
#pragma unroll
    for (int a = 0; a < 2; ++a)
#pragma unroll
        for (int b = 0; b < 2; ++b)
#pragma unroll
            for (int m = 0; m < 4; ++m)
#pragma unroll
                for (int n = 0; n < 2; ++n) acc[a][b][m][n] = (f32x4){0.f, 0.f, 0.f, 0.f};
    bf16x8 At[4][2], B0[2][2], B1[2][2];
    const char* cA = (const char*)g.A + (size_t)cur.pm * tstepA; const char* cB = (const char*)g.Bt + (size_t)cur.pn * tstepB;
    S.a_ready(cur);
    if constexpr (SP2) {
        PG8_STAGE(PG8_SB(0, 0), cB, voffB); PG8_STAGE(PG8_SB(0, 1), cB + hstepB, voffB); PG8_STAGE(PG8_SA(0, 0), cA, voffA); PG8_STAGE(PG8_SA(0, 1), cA + hstepA, voffA);
        if (wr == 1) PG8_BAR;
        PG8_WAIT_V(2); PG8_BAR;
        PG8_STAGE(PG8_SB(1, 0), cB + kstep, voffB); PG8_STAGE(PG8_SA(1, 0), cA + kstep, voffA); PG8_STAGE(PG8_SB(1, 1), cB + hstepB + kstep, voffB);
        PG8_WAIT_V(6); PG8_BAR;
    } else {
        PG8_STAGE(PG8_SB(0, 0), cB, voffB); PG8_STAGE(PG8_SA(0, 0), cA, voffA); PG8_STAGE(PG8_SB(0, 1), cB + hstepB, voffB); PG8_STAGE(PG8_SA(0, 1), cA + hstepA, voffA);
        if (wr == 1) PG8_BAR;
        PG8_WAIT_V(4); PG8_BAR;
        PG8_STAGE(PG8_SB(1, 0), cB + kstep, voffB); PG8_STAGE(PG8_SA(1, 0), cA + kstep, voffA); PG8_STAGE(PG8_SB(1, 1), cB + hstepB + kstep, voffB);
        PG8_WAIT_V(6); PG8_BAR;
    }
    for (;;) {
        const bool has_next = S.next(ui + 1, nxt);
        const char* nA = has_next ? (const char*)g.A + (size_t)nxt.pm * tstepA : cA; const char* nB = has_next ? (const char*)g.Bt + (size_t)nxt.pn * tstepB : cB;
        for (int t = 0; t < nt; t += 2) {
            const bool last = (t == nt - 2);
            const char* a1 = cA + (size_t)(t + 1) * kstep;
            const char* a2 = last ? nA : cA + (size_t)(t + 2) * kstep; const char* b2 = last ? nB : cB + (size_t)(t + 2) * kstep;
            const char* a3 = a2 + kstep; const char* b3 = b2 + kstep;
            if (last && has_next) S.a_ready(nxt);
            if constexpr (SP2) {
            PG8_LDB(B0, 0, 0); PG8_LDB(B1, 0, 1); PG8_SCHED; PG8_LDA(At, 0, 0); PG8_STAGE(PG8_SA(1, 1), a1 + hstepA, voffA);
            PG8_WAIT_V(8); PG8_WAIT_L(0); PG8_BAR; PG8_MMA(0, 0, At, B0); PG8_MMA(0, 1, At, B1); PG8_BAR; PG8_SCHED;
            PG8_LDA(At, 0, 1); PG8_STAGE(PG8_SB(0, 0), b2, voffB); PG8_STAGE(PG8_SB(0, 1), b2 + hstepB, voffB); PG8_STAGE(PG8_SA(0, 0), a2, voffA);
            PG8_WAIT_V(8); PG8_WAIT_L(0); PG8_BAR; PG8_MMA(1, 0, At, B0); PG8_MMA(1, 1, At, B1); PG8_BAR; PG8_SCHED;
            PG8_LDB(B0, 1, 0); PG8_LDB(B1, 1, 1); PG8_SCHED; PG8_LDA(At, 1, 0); PG8_STAGE(PG8_SA(0, 1), a2 + hstepA, voffA);
            PG8_WAIT_V(8); PG8_WAIT_L(0); PG8_BAR; PG8_MMA(0, 0, At, B0); PG8_MMA(0, 1, At, B1); PG8_BAR; PG8_SCHED;
            PG8_LDA(At, 1, 1); PG8_STAGE(PG8_SB(1, 0), b3, voffB); PG8_STAGE(PG8_SB(1, 1), b3 + hstepB, voffB); PG8_STAGE(PG8_SA(1, 0), a3, voffA);
            PG8_WAIT_V(8); PG8_WAIT_L(0); PG8_BAR; PG8_MMA(1, 0, At, B0); PG8_MMA(1, 1, At, B1); PG8_BAR; PG8_SCHED;
            } else {
            PG8_LDB(B0, 0, 0); PG8_SCHED; PG8_LDA(At, 0, 0); PG8_STAGE(PG8_SA(1, 1), a1 + hstepA, voffA);
            PG8_WAIT_L(8); PG8_BAR; PG8_WAIT_L(0); PG8_MMA(0, 0, At, B0); PG8_BAR; PG8_SCHED;
            PG8_LDB(B1, 0, 1); PG8_STAGE(PG8_SB(0, 0), b2, voffB);
            PG8_BAR; PG8_WAIT_L(0); PG8_MMA(0, 1, At, B1); PG8_BAR;
            PG8_LDA(At, 0, 1); PG8_STAGE(PG8_SA(0, 0), a2, voffA);
            PG8_BAR; PG8_WAIT_L(0); PG8_MMA(1, 0, At, B0); PG8_BAR; PG8_SCHED;
            PG8_STAGE(PG8_SB(0, 1), b2 + hstepB, voffB);
            PG8_WAIT_V(6); PG8_BAR; PG8_MMA(1, 1, At, B1); PG8_BAR;
            PG8_LDB(B0, 1, 0); PG8_SCHED; PG8_LDA(At, 1, 0); PG8_STAGE(PG8_SA(0, 1), a2 + hstepA, voffA);
            PG8_WAIT_L(8); PG8_BAR; PG8_WAIT_L(0); PG8_MMA(0, 0, At, B0); PG8_BAR; PG8_SCHED;
            PG8_LDB(B1, 1, 1); PG8_STAGE(PG8_SB(1, 0), b3, voffB);
            PG8_BAR; PG8_WAIT_L(0); PG8_MMA(0, 1, At, B1); PG8_BAR;
            PG8_LDA(At, 1, 1); PG8_STAGE(PG8_SA(1, 0), a3, voffA);
            PG8_BAR; PG8_WAIT_L(0); PG8_MMA(1, 0, At, B0); PG8_BAR; PG8_SCHED;
            PG8_STAGE(PG8_SB(1, 1), b3 + hstepB, voffB);
            PG8_WAIT_V(6); PG8_BAR; PG8_MMA(1, 1, At, B1); PG8_BAR;
            }
        }
        if constexpr (ALIGN_EPI) { if (wr == 0) PG8_BAR; }
        if constexpr (!Epi::AFTER_DRAIN) { E(acc, cur, wr, wc, fr, fq); S.done(cur); }
        if (!has_next) break;
#pragma unroll
        for (int a = 0; a < 2; ++a)
#pragma unroll
            for (int b = 0; b < 2; ++b)
#pragma unroll
                for (int m = 0; m < 4; ++m)
#pragma unroll
                    for (int n = 0; n < 2; ++n) acc[a][b][m][n] = (f32x4){0.f, 0.f, 0.f, 0.f};
        cur = nxt; cA = nA; cB = nB; ++ui;
        if constexpr (ALIGN_EPI) { if (wr == 1) PG8_BAR; }
    }
    PG8_WAIT_V(0);
    if constexpr (!ALIGN_EPI) { if (wr == 0) PG8_BAR; }
    PG8_BAR;
    if constexpr (Epi::AFTER_DRAIN) { E.fused(acc, cur, wr, wc, fr, fq, lds, wid, lane); S.done(cur); }
#undef PG8_SA
#undef PG8_SB
#undef PG8_STAGE
#undef PG8_LDA
#undef PG8_LDB
#undef PG8_MMA
#undef PG8_WAIT_V
#undef PG8_WAIT_L
#undef PG8_WAIT_V_SEL
#undef PG8_BAR
#undef PG8_SCHED
}
}
constexpr int NWAVES = 8;
#ifndef MK_N_LAUNCHES
#define MK_N_LAUNCHES 1
#endif
constexpr int NB = 16, SEQ = 2048, D = 1024, M = NB * SEQ, FF = 4096, DEPTH = 4;
constexpr int AIN = 3088, AQ = 3072, NH = 8, DK = 64, DV = 128, CH = 128, NCH = SEQ / CH;
constexpr int GFFN = 4096, GHALF = 2048, NGRP = 16;
constexpr float EPS = 1e-6f, GATE_CAP = 15.0f;
constexpr size_t MiB = 1u << 20;
constexpr size_t WS_CTL = 0, CTL_ZERO_BYTES = 1 * MiB;
constexpr size_t WS_MOD = 1 * MiB;
constexpr size_t WS_GW = 3 * MiB;
constexpr size_t WS_GATES = 6 * MiB;
constexpr size_t WS_STATS = 8 * MiB;
constexpr size_t WS_W1T = 16 * MiB, WS_W2T = 48 * MiB, WS_AWIN = 80 * MiB, WS_AWOUT = 92 * MiB, WS_BWIN = 96 * MiB, WS_BWOUT = 112 * MiB;
constexpr size_t WS_H = 128 * MiB, WS_X = 192 * MiB, WS_P = 256 * MiB, WS_END = 512 * MiB;
constexpr int CW_TMO = 0, CW_CODE = 1, CW_BAR = 4096;
constexpr int RING_OFF = 0, RING_BYTES = 131072;
constexpr int LDS_BYTES = 147456, LDSCTL_OFF = LDS_BYTES - 512, MISC_OFF = LDSCTL_OFF + 320;

#define GAS __attribute__((address_space(1)))
#define LAS __attribute__((address_space(3)))
typedef unsigned short bf16;
typedef unsigned v4u __attribute__((ext_vector_type(4)));
typedef unsigned v2u __attribute__((ext_vector_type(2)));
typedef float f32x4 __attribute__((ext_vector_type(4)));
typedef float f32x2 __attribute__((ext_vector_type(2)));
typedef short bf16x8 __attribute__((ext_vector_type(8)));
typedef short v4i16_t __attribute__((ext_vector_type(4)));
typedef GAS unsigned gu32;
#define RLX_AGENT __ATOMIC_RELAXED, __HIP_MEMORY_SCOPE_AGENT
#define LDS_WAIT() asm volatile("s_waitcnt lgkmcnt(0)" ::: "memory")
#define VM_WAIT() asm volatile("s_waitcnt vmcnt(0)" ::: "memory")
__device__ __forceinline__ unsigned f2bf(float f) { unsigned u = __builtin_bit_cast(unsigned, f); return (u + 0x7fffu + ((u >> 16) & 1u)) >> 16; }
__device__ __forceinline__ unsigned pk2(float lo, float hi) { unsigned r; asm("v_cvt_pk_bf16_f32 %0, %1, %2" : "=v"(r) : "v"(lo), "v"(hi)); return r; }
__device__ __forceinline__ float frcp(float x) { return __builtin_amdgcn_rcpf(x); }
__device__ __forceinline__ float frsq(float x) { return __builtin_amdgcn_rsqf(x); }
__device__ __forceinline__ float bf2f(unsigned short b) { return __builtin_bit_cast(float, (unsigned)b << 16); }
__device__ __forceinline__ float bflo(unsigned w) { return __builtin_bit_cast(float, w << 16); }
__device__ __forceinline__ float bfhi(unsigned w) { return __builtin_bit_cast(float, w & 0xffff0000u); }
#define XB_TMO      128
#define XB_XCNT(j)  (256  + 64 * (j))
#define XB_XSUB(j)  (1280 + 64 * (j))
#define XB_XGEN(j)  (2304 + 64 * (j))
#define XB_TOP      3328
#define XB_TOPGEN   3392
#define XCD_BAR_WORDS 3456
#define XB_SPIN_CAP (1u << 18)

__device__ __forceinline__ unsigned xb_ld(unsigned* p)              { return __hip_atomic_load(p, __ATOMIC_RELAXED, __HIP_MEMORY_SCOPE_AGENT); }
__device__ __forceinline__ unsigned xb_add(unsigned* p, unsigned v) { return __hip_atomic_fetch_add(p, v, __ATOMIC_RELAXED, __HIP_MEMORY_SCOPE_AGENT); }
__device__ __forceinline__ unsigned xb_xcc_id() { return (unsigned)__builtin_amdgcn_s_getreg((3 << 11) | 20) & 0xFu; }
#define XB_SPIN(cond, bar) do { unsigned _sp = 0; while (cond) { __builtin_amdgcn_s_sleep(1); \
    if ((++_sp & 255u) == 0u) { if (xb_ld(&(bar)[XB_TMO])) break; if (_sp > XB_SPIN_CAP) { atomicAdd(&(bar)[XB_TMO], 1u); break; } } } } while (0)

struct XcdBarrier {
    unsigned* bar; unsigned x;
    volatile LAS unsigned* st;
};

__device__ __forceinline__ XcdBarrier xcd_barrier_post(unsigned* bar, volatile LAS unsigned* st) {
    XcdBarrier b; b.bar = bar; b.x = xb_xcc_id(); b.st = st;
    if (threadIdx.x == 0) (void)xb_add(&bar[XB_XCNT(b.x)], 1u);
    return b;
}
__device__ __forceinline__ void xcd_barrier_complete(unsigned* bar, unsigned x, unsigned& nloc, unsigned& nx) {
    const unsigned G = gridDim.x * gridDim.y * gridDim.z;
    unsigned sum, cnt, mine, sp = 0u;
    for (;;) {
        sum = 0u; cnt = 0u; mine = 0u;
#pragma unroll
        for (unsigned j = 0; j < 16; ++j) { const unsigned c = xb_ld(&bar[XB_XCNT(j)]); sum += c; cnt += (c > 0u) ? 1u : 0u; mine = (j == x) ? c : mine; }
        if (sum == G) break;
        __builtin_amdgcn_s_sleep(1);
        if ((++sp & 255u) == 0u) { if (xb_ld(&bar[XB_TMO])) break; if (sp > XB_SPIN_CAP) { atomicAdd(&bar[XB_TMO], 1u); break; } }
    }
    nloc = mine > 0u ? mine : 1u; nx = cnt > 0u ? cnt : 1u;
}

__device__ __forceinline__ void xcd_barrier(const XcdBarrier& b) {
    asm volatile("s_waitcnt vmcnt(0)" ::: "memory");
    __syncthreads();
    if (threadIdx.x == 0) {
        unsigned* bar = b.bar;
        __builtin_amdgcn_s_waitcnt(0);
        unsigned nloc = b.st[0], nx = b.st[1];
        if (nloc == 0u) { xcd_barrier_complete(bar, b.x, nloc, nx); b.st[0] = nloc; b.st[1] = nx; }
        const unsigned old = xb_add(&bar[XB_XSUB(b.x)], 1u);
        const unsigned gen = old / nloc;
        if (old + 1u == (gen + 1u) * nloc) {
            __builtin_amdgcn_fence(__ATOMIC_RELEASE, "agent");
            asm volatile("s_waitcnt vmcnt(0)" ::: "memory");
            const unsigned og = xb_add(&bar[XB_TOP], 1u);
            const unsigned tg = og / nx;
            if (og + 1u == (tg + 1u) * nx) xb_add(&bar[XB_TOPGEN], 1u);
            else XB_SPIN(xb_ld(&bar[XB_TOPGEN]) == tg, bar);
            __builtin_amdgcn_fence(__ATOMIC_ACQUIRE, "agent");
            xb_add(&bar[XB_XGEN(b.x)], 1u);
            asm volatile("s_waitcnt vmcnt(0)" ::: "memory");
        } else {
            XB_SPIN(xb_ld(&bar[XB_XGEN(b.x)]) == gen, bar);
            __builtin_amdgcn_fence(__ATOMIC_ACQUIRE, "agent");
            asm volatile("s_waitcnt vmcnt(0)" ::: "memory");
        }
    }
    __syncthreads();
}
struct Frame {
    LAS unsigned char* lds;
    volatile LAS unsigned* MISC;
    gu32* ctl;
    int tid, lane, wave;
    int vcu, G;
};
__device__ __forceinline__ float wave_sum(float v) {
#pragma unroll
    for (int o = 1; o < 64; o <<= 1) v += __shfl_xor(v, o);
    return v;
}
__device__ __forceinline__ bf16x8 frag_kc(const LAS unsigned char* base, int row, int k, int stride_bytes) {
    return *(const LAS bf16x8*)(base + row * stride_bytes + k * 2);
}
__device__ __forceinline__ bf16x8 frag_tr(const LAS unsigned char* base, int k0, int n0, int stride_bytes, int lane) {
    const int g = lane >> 4, i = lane & 15;
    const LAS unsigned char* p = base + (k0 + 8 * g + (i >> 2)) * stride_bytes + (n0 + 4 * (i & 3)) * 2;
    const v4i16_t lo = __builtin_amdgcn_ds_read_tr16_b64_v4i16((LAS v4i16_t*)p);
    const v4i16_t hi = __builtin_amdgcn_ds_read_tr16_b64_v4i16((LAS v4i16_t*)(p + 4 * stride_bytes));
    return (bf16x8){lo.x, lo.y, lo.z, lo.w, hi.x, hi.y, hi.z, hi.w};
}
#define MFMA16(a, b, c) __builtin_amdgcn_mfma_f32_16x16x32_bf16((a), (b), (c), 0, 0, 0)

__device__ __forceinline__ void p0_transpose_item(const float* W, int ldw, int K, int ncols, bf16* WT, int item, int lane, int sc_lo, int sc_hi, float scl) {
    const int nblk = ncols / 32, kb = item / nblk, nb = item % nblk, k0 = 64 * kb, n0 = 32 * nb, c = lane >> 3, nq = lane & 7;
    const float* src = W + (size_t)(k0 + 8 * c) * ldw + n0 + 4 * nq;
    f32x4 v[8];
#pragma unroll
    for (int t = 0; t < 8; ++t) v[t] = *(const f32x4*)(src + (size_t)t * ldw);
    const float f = (n0 >= sc_lo && n0 < sc_hi) ? scl : 1.0f;
#pragma unroll
    for (int i = 0; i < 4; ++i) { v4u o; o.x = pk2(v[0][i] * f, v[1][i] * f); o.y = pk2(v[2][i] * f, v[3][i] * f); o.z = pk2(v[4][i] * f, v[5][i] * f); o.w = pk2(v[6][i] * f, v[7][i] * f);
        *(v4u*)(WT + (size_t)(n0 + 4 * nq + i) * K + k0 + 8 * c) = o; }
}
struct In {
    const float *x, *c, *norm_g, *ada_w, *ada_b, *ffn_w1, *ffn_w2, *a_w_in, *a_b_if, *a_hnorm_g, *a_w_out, *b_w_in, *b_b_in, *b_ln_g, *b_ln_b, *b_ws, *b_bs, *b_w_out;
};
__device__ __forceinline__ void p0_prologue(Frame& F, const In& I, unsigned char* ws) {
    __syncthreads();
    float* mod = (float*)(ws + WS_MOD);
#if defined(PROBE_P0MOD)
    for (int rep_ = 0; rep_ < 2; ++rep_)
#endif
    for (int task = F.vcu; task < DEPTH * 64; task += F.G) {
        const int li = task / 64, n0 = (task % 64) * 96;
        LAS float* cact = (LAS float*)(F.lds);
        LAS float* part = (LAS float*)(F.lds + 65536);
        { float cv[32];
#pragma unroll
          for (int j = 0; j < 32; ++j) { const int i = F.tid + 512 * j; cv[j] = I.c[(i & 15) * D + (i >> 4)]; }
#pragma unroll
          for (int j = 0; j < 32; ++j) { const float v = cv[j]; cact[F.tid + 512 * j] = v * frcp(1.0f + __expf(-v)); } }
        __syncthreads();
        f32x2 acc[16];
#pragma unroll
        for (int b = 0; b < 16; ++b) acc[b] = (f32x2){0.f, 0.f};
        const int ln = F.lane < 48 ? F.lane : 47;
        const float* Wp = I.ada_w + ((size_t)li * D + F.wave * 128) * (6 * D) + n0 + 2 * ln;
#pragma unroll 1
        for (int k0 = 0; k0 < 128; k0 += 16) {
            f32x2 wv[16];
#pragma unroll
            for (int kk = 0; kk < 16; ++kk) wv[kk] = *(const f32x2*)(Wp + (size_t)(k0 + kk) * (6 * D));
#pragma unroll
            for (int kk = 0; kk < 16; ++kk) {
                const LAS f32x4* cp = (const LAS f32x4*)(cact + (F.wave * 128 + k0 + kk) * 16);
                const f32x4 c0 = cp[0], c1 = cp[1], c2 = cp[2], c3 = cp[3];
                acc[0] += wv[kk] * c0[0]; acc[1] += wv[kk] * c0[1]; acc[2] += wv[kk] * c0[2]; acc[3] += wv[kk] * c0[3];
                acc[4] += wv[kk] * c1[0]; acc[5] += wv[kk] * c1[1]; acc[6] += wv[kk] * c1[2]; acc[7] += wv[kk] * c1[3];
                acc[8] += wv[kk] * c2[0]; acc[9] += wv[kk] * c2[1]; acc[10] += wv[kk] * c2[2]; acc[11] += wv[kk] * c2[3];
                acc[12] += wv[kk] * c3[0]; acc[13] += wv[kk] * c3[1]; acc[14] += wv[kk] * c3[2]; acc[15] += wv[kk] * c3[3];
            }
        }
#pragma unroll
        for (int b = 0; b < 16; ++b) *(LAS f32x2*)(part + (F.wave * 16 + b) * 128 + 2 * ln) = acc[b];
        __syncthreads();
        for (int idx = F.tid; idx < 16 * 96; idx += NWAVES * 64) { const int b = idx / 96, n = idx % 96; float s = I.ada_b[li * 6 * D + n0 + n];
#pragma unroll
            for (int w = 0; w < 8; ++w) s += part[(w * 16 + b) * 128 + n];
            mod[((size_t)li * NB + b) * (6 * D) + n0 + n] = s; }
        __syncthreads();
    }
    { float* GW = (float*)(ws + WS_GW); const int gt = F.vcu * NWAVES * 64 + F.tid, NT = F.G * NWAVES * 64;
      for (int i = gt; i < 2 * 16 * D; i += NT) { const int j = i >> 14, g = (i >> 10) & 15, k = i & 1023; GW[i] = I.a_w_in[((size_t)j * D + k) * AIN + AQ + g]; } }
    const int gw = F.vcu * NWAVES + F.wave, NGW = F.G * NWAVES;
    constexpr int I_W1 = (D / 64) * (FF / 32), I_W2 = (FF / 64) * (D / 32), I_AI = (D / 64) * (AQ / 32), I_AO = (D / 64) * (D / 32), I_BI = (D / 64) * (GFFN / 32), I_BO = (GHALF / 64) * (D / 32);
    constexpr int NITEMS = 4 * I_W1 + 4 * I_W2 + 2 * I_AI + 2 * I_AO + 2 * I_BI + 2 * I_BO;
#if defined(PROBE_P0TR)
    for (int rep_ = 0; rep_ < 2; ++rep_)
#endif
    for (int it = gw; it < NITEMS; it += NGW) {
        int r = it;
        if (r < 4 * I_W1) { const int l = r / I_W1; p0_transpose_item(I.ffn_w1 + (size_t)l * D * FF, FF, D, FF, (bf16*)(ws + WS_W1T) + (size_t)l * D * FF, r % I_W1, F.lane, 0, 0, 1.f); continue; } r -= 4 * I_W1;
        if (r < 4 * I_W2) { const int l = r / I_W2; p0_transpose_item(I.ffn_w2 + (size_t)l * D * FF, D, FF, D, (bf16*)(ws + WS_W2T) + (size_t)l * D * FF, r % I_W2, F.lane, 0, 0, 1.f); continue; } r -= 4 * I_W2;
        if (r < 2 * I_AI) { const int l = r / I_AI; p0_transpose_item(I.a_w_in + (size_t)l * D * AIN, AIN, D, AQ, (bf16*)(ws + WS_AWIN) + (size_t)l * AQ * D, r % I_AI, F.lane, 512, 1024, 0.125f); continue; } r -= 2 * I_AI;
        if (r < 2 * I_AO) { const int l = r / I_AO; p0_transpose_item(I.a_w_out + (size_t)l * D * D, D, D, D, (bf16*)(ws + WS_AWOUT) + (size_t)l * D * D, r % I_AO, F.lane, 0, 0, 1.f); continue; } r -= 2 * I_AO;
        if (r < 2 * I_BI) { const int l = r / I_BI; p0_transpose_item(I.b_w_in + (size_t)l * D * GFFN, GFFN, D, GFFN, (bf16*)(ws + WS_BWIN) + (size_t)l * D * GFFN, r % I_BI, F.lane, 0, 0, 1.f); continue; } r -= 2 * I_BI;
        { const int l = r / I_BO; p0_transpose_item(I.b_w_out + (size_t)l * GHALF * D, D, GHALF, D, (bf16*)(ws + WS_BWOUT) + (size_t)l * GHALF * D, r % I_BO, F.lane, 0, 0, 1.f); }
    }
}

template <bool HAS_Y, bool WRITE_H, bool GATES, bool XIN_F32, bool XOUT_F32>
__device__ __forceinline__ void nrn_phase(Frame& F, const void* xin_, void* xout_, const bf16* Y, bf16* H, const float* ng_a, const float* gmod  ,
                                          const float* ng_b, const float* scmod, const float* shmod, const float* GW  , const float* b_if, float* gates) {
    LAS float* gwl = (LAS float*)(F.lds);
    const float* xin = (const float*)xin_; const bf16* xinb = (const bf16*)xin_; float* xout = (float*)xout_; bf16* xoutb = (bf16*)xout_;
#define NRN_LDX(dst, row_) do { _Pragma("unroll") for (int j = 0; j < 4; ++j) { if (XIN_F32) dst[j] = *(const f32x4*)(xin + (row_) * D + 4 * lane + 256 * j); \
        else { const v2u w_ = *(const v2u*)(xinb + (row_) * D + 4 * lane + 256 * j); dst[j] = (f32x4){bflo(w_.x), bfhi(w_.x), bflo(w_.y), bfhi(w_.y)}; } } } while (0)
    if (GATES) { for (int i = F.tid; i < 16 * D / 4; i += NWAVES * 64) ((LAS f32x4*)gwl)[i] = ((const f32x4*)GW)[i]; __syncthreads(); }
    const int gw = F.vcu * NWAVES + F.wave, NGW = F.G * NWAVES, lane = F.lane;
#pragma unroll 1
    for (int blk = gw; blk < M / 16; blk += NGW) {
        const int b = (blk * 16) / SEQ;
        f32x4 ga[4], hb[4], hs[4];
#pragma unroll
        for (int j = 0; j < 4; ++j) { const int col = 4 * lane + 256 * j;
            if (HAS_Y) ga[j] = *(const f32x4*)(gmod + (size_t)b * 6 * D + col) * *(const f32x4*)(ng_a + col);
            if (WRITE_H) { hb[j] = *(const f32x4*)(ng_b + col) * (*(const f32x4*)(scmod + (size_t)b * 6 * D + col) + 1.0f); hs[j] = *(const f32x4*)(shmod + (size_t)b * 6 * D + col); } }
        f32x4 xn[4]; v2u yn[4];
        { const size_t row = (size_t)blk * 16;
#pragma unroll
          for (int j = 0; j < 4; ++j) { if (HAS_Y) yn[j] = *(const v2u*)(Y + row * D + 4 * lane + 256 * j); }
          NRN_LDX(xn, row); }
#pragma unroll 1
        for (int rr = 0; rr < 16; ++rr) {
            const size_t row = (size_t)blk * 16 + rr;
            f32x4 xv[4]; v2u yw[4];
#pragma unroll
            for (int j = 0; j < 4; ++j) { xv[j] = xn[j]; if (HAS_Y) yw[j] = yn[j]; }
            if (rr + 1 < 16) {
#pragma unroll
                for (int j = 0; j < 4; ++j) { if (HAS_Y) yn[j] = *(const v2u*)(Y + (row + 1) * D + 4 * lane + 256 * j); }
                NRN_LDX(xn, row + 1); }
            if (HAS_Y) {
                f32x4 yv[4]; float s = 0.f;
#pragma unroll
                for (int j = 0; j < 4; ++j) { const v2u w = yw[j]; yv[j] = (f32x4){bflo(w.x), bfhi(w.x), bflo(w.y), bfhi(w.y)};
                    s += (yv[j][0] * yv[j][0] + yv[j][1] * yv[j][1]) + (yv[j][2] * yv[j][2] + yv[j][3] * yv[j][3]); }
                const float ry = frsq(wave_sum(s) * (1.0f / D) + EPS);
#pragma unroll
                for (int j = 0; j < 4; ++j) { xv[j] = xv[j] + ga[j] * (yv[j] * ry);
                    if (XOUT_F32) *(f32x4*)(xout + row * D + 4 * lane + 256 * j) = xv[j];
                    else { v2u w_; w_.x = pk2(xv[j][0], xv[j][1]); w_.y = pk2(xv[j][2], xv[j][3]); *(v2u*)(xoutb + row * D + 4 * lane + 256 * j) = w_; } }
            }
            if (WRITE_H) {
                float s = 0.f;
#pragma unroll
                for (int j = 0; j < 4; ++j) s += (xv[j][0] * xv[j][0] + xv[j][1] * xv[j][1]) + (xv[j][2] * xv[j][2] + xv[j][3] * xv[j][3]);
                const float rx = frsq(wave_sum(s) * (1.0f / D) + EPS);
                f32x4 hv[4];
#pragma unroll
                for (int j = 0; j < 4; ++j) { hv[j] = (xv[j] * rx) * hb[j] + hs[j];
                    v2u w; w.x = pk2(hv[j][0], hv[j][1]); w.y = pk2(hv[j][2], hv[j][3]); *(v2u*)(H + row * D + 4 * lane + 256 * j) = w; }
                if (GATES) {
                    float p[16];
#pragma unroll
                    for (int g = 0; g < 16; ++g) { float a = 0.f;
#pragma unroll
                        for (int j = 0; j < 4; ++j) { const f32x4 wv = *(const LAS f32x4*)(gwl + g * D + 4 * lane + 256 * j); a += (hv[j][0] * wv[0] + hv[j][1] * wv[1]) + (hv[j][2] * wv[2] + hv[j][3] * wv[3]); }
                        p[g] = a; asm volatile("" : "+v"(p[g]) :: "memory"); }
                    float q8[8], q4[4], q2[2], q1;
                    { const bool hi = (lane & 32) != 0;
#pragma unroll
                      for (int i = 0; i < 8; ++i) { const float send = hi ? p[i] : p[i + 8], keep = hi ? p[i + 8] : p[i]; q8[i] = keep + __shfl_xor(send, 32); } }
                    { const bool hi = (lane & 16) != 0;
#pragma unroll
                      for (int i = 0; i < 4; ++i) { const float send = hi ? q8[i] : q8[i + 4], keep = hi ? q8[i + 4] : q8[i]; q4[i] = keep + __shfl_xor(send, 16); } }
                    { const bool hi = (lane & 8) != 0;
#pragma unroll
                      for (int i = 0; i < 2; ++i) { const float send = hi ? q4[i] : q4[i + 2], keep = hi ? q4[i + 2] : q4[i]; q2[i] = keep + __shfl_xor(send, 8); } }
                    { const bool hi = (lane & 4) != 0; const float send = hi ? q2[0] : q2[1], keep = hi ? q2[1] : q2[0]; q1 = keep + __shfl_xor(send, 4); }
                    q1 += __shfl_xor(q1, 2); q1 += __shfl_xor(q1, 1);
                    if ((lane & 3) == 0) { const int g = lane >> 2; const float pre = q1 + b_if[g]; const float cp = GATE_CAP * tanhf(pre * (1.0f / GATE_CAP));
                        gates[row * 16 + g] = (g < 8) ? cp : -log1pf(expf(-cp)); }
                }
            }
        }
    }
    if (GATES) __syncthreads();
#undef NRN_LDX
}
constexpr int ML_QS = 0, ML_KS = 18432, ML_VS = 36864, ML_SS = 75776, ML_CT = 110592, ML_G = 131328;
constexpr int ML_SPLIT = 9;
constexpr int ML_QSTR = 144, ML_VSTR = 304, ML_SSTR = 272, ML_CSTR = 144;
static_assert(ML_G + 4 * 512 + 64 <= LDSCTL_OFF, "mLSTM LDS images fit below the control words");
__device__ __forceinline__ void mlstm_unit(Frame& F, int b, int h, int c_begin, int c_full, int c_end, const bf16* P, const float* gates, const float* hng, bf16* HH) {
    const int tid = F.tid, lane = F.lane, w = F.wave, c16 = lane & 15, q = lane >> 4;
    LAS unsigned char* Qs = F.lds + ML_QS; LAS unsigned char* Ks = F.lds + ML_KS; LAS unsigned char* Vs = F.lds + ML_VS;
    LAS unsigned char* Ssw = F.lds + ML_SS + w * (16 * ML_SSTR); LAS unsigned char* Cts = F.lds + ML_CT;
    LAS float* g_bc = (LAS float*)(F.lds + ML_G); LAS float* g_ii = g_bc + 128; LAS float* g_w = g_bc + 256; LAS float* g_eb = g_bc + 384; LAS float* g_tot = g_bc + 512;
    for (int i = tid; i < 144 * ML_CSTR / 4; i += NWAVES * 64) ((LAS unsigned*)Cts)[i] = 0u;
    for (int i = tid; i < 128 * 12; i += NWAVES * 64) { const int l = i / 12, cpair = i % 12; ((LAS unsigned*)(Vs + l * ML_VSTR + 256))[cpair] = (cpair == 0) ? 0x00003F80u : 0u; }
    const int dt = w & 3, eh = w >> 2;
    f32x4 st[5];
#pragma unroll
    for (int k = 0; k < 5; ++k) st[k] = (f32x4){0.f, 0.f, 0.f, 0.f};
    const int irow = 16 * w + c16;
    v4u qreg[2], kreg[2], vreg[4]; v2u onx[8]; float lf_own = 0.f, lf_oth = 0.f, ii_own = 0.f;
#define ML_PREFETCH(cc, wantq) do { const size_t r0_ = (size_t)b * SEQ + (size_t)(cc) * CH; \
        _Pragma("unroll") for (int i = 0; i < 2; ++i) { const int ci = tid + 512 * i, l = ci >> 3, ch = ci & 7; const bf16* src = P + (r0_ + l) * AQ + h * DK + ch * 8; if (wantq) qreg[i] = *(const v4u*)src; kreg[i] = *(const v4u*)(src + 512); } \
        _Pragma("unroll") for (int i = 0; i < 4; ++i) { const int ci = tid + 512 * i, l = ci >> 4, ch = ci & 15; vreg[i] = *(const v4u*)(P + (r0_ + l) * AQ + 1024 + h * DV + ch * 8); } \
        if (wantq) { _Pragma("unroll") for (int et = 0; et < 8; ++et) onx[et] = *(const v2u*)(P + (r0_ + irow) * AQ + 2048 + h * DV + 16 * et + 4 * q); } \
        if (w < 2) { const int t_ = 64 * w + lane, o_ = 64 * (1 - w) + lane; ii_own = gates[(r0_ + t_) * 16 + h]; lf_own = gates[(r0_ + t_) * 16 + 8 + h]; lf_oth = gates[(r0_ + o_) * 16 + 8 + h]; } } while (0)
    ML_PREFETCH(c_begin, c_begin >= c_full);
    __syncthreads();
    for (int c = c_begin; c < c_end; ++c) {
        const bool full = c >= c_full;
        const size_t r0 = (size_t)b * SEQ + (size_t)c * CH;
        if (w < 2) { float x = lf_own;
#pragma unroll
            for (int o = 1; o < 64; o <<= 1) { const float y = __shfl_up(x, o); if (lane >= o) x += y; }
            const float tot_own = __shfl(x, 63), tot_oth = wave_sum(lf_oth);
            const float blast_ = tot_own + tot_oth, bc = x + (w == 1 ? tot_oth : 0.f);
            const int t = 64 * w + lane;
            g_bc[t] = bc; g_ii[t] = ii_own; g_w[t] = __expf(blast_ - bc + ii_own); g_eb[t] = __expf(bc);
            if (tid == 0) g_tot[0] = blast_; }
#pragma unroll
        for (int i = 0; i < 2; ++i) { const int ci = tid + 512 * i, l = ci >> 3, ch = ci & 7; if (full) *(LAS v4u*)(Qs + l * ML_QSTR + ch * 16) = qreg[i]; *(LAS v4u*)(Ks + l * ML_QSTR + ch * 16) = kreg[i]; }
#pragma unroll
        for (int i = 0; i < 4; ++i) { const int ci = tid + 512 * i, l = ci >> 4, ch = ci & 15; *(LAS v4u*)(Vs + l * ML_VSTR + ch * 16) = vreg[i]; }
        v2u ocur[8];
#pragma unroll
        for (int et = 0; et < 8; ++et) ocur[et] = onx[et];
        if (c + 1 < c_end) { const bool nfull = (c + 1) >= c_full; ML_PREFETCH(c + 1, nfull); }
        __syncthreads();
        const float blast = g_tot[0];
        if (full) {
            const float bci = g_bc[irow];
            bf16x8 qf[2]; qf[0] = frag_kc(Qs, irow, 8 * q, ML_QSTR); qf[1] = frag_kc(Qs, irow, 32 + 8 * q, ML_QSTR);
            for (int jt = 0; jt <= w; ++jt) {
                f32x4 s = (f32x4){0.f, 0.f, 0.f, 0.f};
#pragma unroll
                for (int kk = 0; kk < 2; ++kk) { const bf16x8 kf = frag_kc(Ks, 16 * jt + c16, 32 * kk + 8 * q, ML_QSTR); s = MFMA16(kf, qf[kk], s); }
                const f32x4 bcj = *(const LAS f32x4*)(g_bc + 16 * jt + 4 * q), iij = *(const LAS f32x4*)(g_ii + 16 * jt + 4 * q);
#pragma unroll
                for (int r = 0; r < 4; ++r) { const int j = 16 * jt + 4 * q + r; const float d = (j <= irow) ? __expf(bci - bcj[r] + iij[r]) : 0.f; s[r] = (j <= irow) ? s[r] * d : 0.f; }
                v2u pw; pw.x = pk2(s[0], s[1]); pw.y = pk2(s[2], s[3]);
                *(LAS v2u*)(Ssw + c16 * ML_SSTR + (16 * jt + 4 * q) * 2) = pw;
            }
            if ((w & 1) == 0) *(LAS v2u*)(Ssw + c16 * ML_SSTR + (16 * (w + 1) + 4 * q) * 2) = (v2u){0u, 0u};
            f32x4 acc[9];
#pragma unroll
            for (int et = 0; et < 9; ++et) { f32x4 a = (f32x4){0.f, 0.f, 0.f, 0.f};
#pragma unroll
                for (int kk = 0; kk < 2; ++kk) { const bf16x8 cf = frag_kc(Cts, 16 * et + c16, 32 * kk + 8 * q, ML_CSTR); a = MFMA16(cf, qf[kk], a); }
                acc[et] = a; }
            { const float ebi = g_eb[irow];
#pragma unroll
              for (int et = 0; et < 9; ++et) acc[et] = acc[et] * ebi; }
            const int nks = (w + 2) >> 1;
            for (int ks = 0; ks < nks; ++ks) {
                const bf16x8 sf = frag_kc(Ssw, c16, 32 * ks + 8 * q, ML_SSTR);
#pragma unroll
                for (int et = 0; et < 9; ++et) { const bf16x8 vf = frag_tr(Vs, 32 * ks, 16 * et, ML_VSTR, lane); acc[et] = MFMA16(vf, sf, acc[et]); }
            }
            { const float den = __shfl(acc[8][0], c16);
              const float inv = frcp(fmaxf(fabsf(den), 1.0f));
              float ss = 0.f;
#pragma unroll
              for (int et = 0; et < 8; ++et) { acc[et] = acc[et] * inv; ss += (acc[et][0] * acc[et][0] + acc[et][1] * acc[et][1]) + (acc[et][2] * acc[et][2] + acc[et][3] * acc[et][3]); }
              ss += __shfl_xor(ss, 16); ss += __shfl_xor(ss, 32);
              const float rn = frsq(ss * (1.0f / DV) + EPS);
              const size_t row = r0 + irow;
#pragma unroll
              for (int et = 0; et < 8; ++et) { const int e0 = 16 * et + 4 * q;
                  const v2u ow = ocur[et];
                  const f32x4 gv = *(const f32x4*)(hng + h * DV + e0);
                  const float o0 = bflo(ow.x), o1 = bfhi(ow.x), o2 = bflo(ow.y), o3 = bfhi(ow.y);
                  const float y0 = acc[et][0] * rn * gv[0] * frcp(1.0f + __expf(-o0)), y1 = acc[et][1] * rn * gv[1] * frcp(1.0f + __expf(-o1));
                  const float y2 = acc[et][2] * rn * gv[2] * frcp(1.0f + __expf(-o2)), y3 = acc[et][3] * rn * gv[3] * frcp(1.0f + __expf(-o3));
                  v2u pw; pw.x = pk2(y0, y1); pw.y = pk2(y2, y3);
                  *(v2u*)(HH + row * D + h * DV + e0) = pw; } }
        }
        { const float dec = __expf(blast);
#pragma unroll
          for (int k = 0; k < 5; ++k) st[k] = st[k] * dec;
#pragma unroll
          for (int ks = 0; ks < 4; ++ks) {
              bf16x8 kf = frag_tr(Ks, 32 * ks, 16 * dt, ML_QSTR, lane);
              const f32x4 w0 = *(const LAS f32x4*)(g_w + 32 * ks + 8 * q), w1 = *(const LAS f32x4*)(g_w + 32 * ks + 8 * q + 4);
              { const unsigned a0 = pk2(bf2f((unsigned short)kf[0]) * w0[0], bf2f((unsigned short)kf[1]) * w0[1]), a1 = pk2(bf2f((unsigned short)kf[2]) * w0[2], bf2f((unsigned short)kf[3]) * w0[3]);
                const unsigned a2 = pk2(bf2f((unsigned short)kf[4]) * w1[0], bf2f((unsigned short)kf[5]) * w1[1]), a3 = pk2(bf2f((unsigned short)kf[6]) * w1[2], bf2f((unsigned short)kf[7]) * w1[3]);
                kf = __builtin_bit_cast(bf16x8, (v4u){a0, a1, a2, a3}); }
#pragma unroll
              for (int k = 0; k < 5; ++k) { const int et = eh + 2 * k; if (et < 9) { const bf16x8 vf = frag_tr(Vs, 32 * ks, 16 * et, ML_VSTR, lane); st[k] = MFMA16(kf, vf, st[k]); } }
          } }
        __syncthreads();
#pragma unroll
        for (int k = 0; k < 5; ++k) { const int et = eh + 2 * k; if (et < 9) { v2u pw; pw.x = pk2(st[k][0], st[k][1]); pw.y = pk2(st[k][2], st[k][3]);
            *(LAS v2u*)(Cts + (16 * et + c16) * ML_CSTR + (16 * dt + 4 * q) * 2) = pw; } }
    }
    __syncthreads();
#undef ML_PREFETCH
}

constexpr int SG_AS = 0, SG_VS = 34816, SG_F = 69632;
constexpr int SG_STR = 272;
__device__ __forceinline__ void sgu_block(Frame& F, int b, int n, bf16* Z, const f32x2* stats, const float* wsl  , const float* bsl  , const float* lng, const float* lnb  ) {
    const int tid = F.tid, lane = F.lane, w = F.wave, c16 = lane & 15, q = lane >> 4;
    LAS unsigned char* As = F.lds + SG_AS; LAS unsigned char* Vs = F.lds + SG_VS;
    LAS float* f_mu = (LAS float*)(F.lds + SG_F); LAS float* f_rs = f_mu + 128; LAS float* f_r1 = f_mu + 256; LAS float* f_r2 = f_mu + 384;
    const size_t r0 = (size_t)b * SEQ + (size_t)n * CH;
    const int trow = 16 * w + c16, nks = (w + 2) >> 1;
    v4u vreg[4]; f32x4 wa[4], wc_[4]; v2u ureg[8];
#define SG_PREFETCH(gg) do { \
        _Pragma("unroll") for (int i = 0; i < 4; ++i) { const int ci = tid + 512 * i, l = ci >> 4, ch = ci & 15; vreg[i] = *(const v4u*)(Z + (r0 + l) * GFFN + GHALF + (gg) * 128 + ch * 8); } \
        _Pragma("unroll") for (int i = 0; i < 4; ++i) { const int ci = tid + 512 * i, t = ci >> 4, s0 = (ci & 15) * 8; const float* wp = wsl + ((size_t)(gg) * CH + t) * CH + s0; \
            if (s0 <= t) { wa[i] = *(const f32x4*)wp; wc_[i] = *(const f32x4*)(wp + 4); } } \
        _Pragma("unroll") for (int ct = 0; ct < 8; ++ct) ureg[ct] = *(const v2u*)(Z + (r0 + trow) * GFFN + (gg) * 128 + 16 * ct + 4 * q); } while (0)
    const int grot = F.vcu & 15;
    SG_PREFETCH(grot);
    if (tid < 128) { const f32x4* sp = (const f32x4*)(stats + (r0 + tid) * 32); float s = 0.f, s2 = 0.f;
#pragma unroll
        for (int i = 0; i < 16; ++i) { const f32x4 v = sp[i]; s += v[0] + v[2]; s2 += v[1] + v[3]; }
        const float mu = s * (1.0f / GHALF), var = fmaxf(s2 * (1.0f / GHALF) - mu * mu, 0.f);
        f_mu[tid] = mu; f_rs[tid] = frsq(var + EPS); }
    __syncthreads();
#pragma unroll 1
    for (int gi = 0; gi < NGRP; ++gi) { const int g = (gi + grot) & 15;
#pragma unroll
        for (int i = 0; i < 4; ++i) { const int ci = tid + 512 * i, l = ci >> 4, ch = ci & 15; *(LAS v4u*)(Vs + l * SG_STR + ch * 16) = vreg[i]; }
#pragma unroll
        for (int i = 0; i < 4; ++i) { const int ci = tid + 512 * i, t = ci >> 4, s0 = (ci & 15) * 8; float r1 = 0.f, r2 = 0.f; unsigned pw[4] = {0u, 0u, 0u, 0u};
            if (s0 <= t) { const f32x4 a = wa[i], c = wc_[i];
                const f32x4 ra = *(const LAS f32x4*)(f_rs + s0), rc = *(const LAS f32x4*)(f_rs + s0 + 4), ma = *(const LAS f32x4*)(f_mu + s0), mc = *(const LAS f32x4*)(f_mu + s0 + 4);
                float e[8];
#pragma unroll
                for (int k = 0; k < 4; ++k) { const float va = (s0 + k <= t) ? a[k] : 0.f, vc = (s0 + 4 + k <= t) ? c[k] : 0.f; r2 += va + vc; e[k] = va * ra[k]; e[4 + k] = vc * rc[k]; }
#pragma unroll
                for (int k = 0; k < 4; ++k) pw[k] = pk2(e[2 * k], e[2 * k + 1]);
#pragma unroll
                for (int k = 0; k < 4; ++k) { r1 += bflo(pw[k]) * ((2 * k < 4) ? ma[2 * k] : mc[2 * k - 4]) + bfhi(pw[k]) * ((2 * k + 1 < 4) ? ma[2 * k + 1] : mc[2 * k + 1 - 4]); } }
            *(LAS v4u*)(As + t * SG_STR + s0 * 2) = (v4u){pw[0], pw[1], pw[2], pw[3]};
            r1 += __shfl_xor(r1, 1); r1 += __shfl_xor(r1, 2); r1 += __shfl_xor(r1, 4); r1 += __shfl_xor(r1, 8);
            r2 += __shfl_xor(r2, 1); r2 += __shfl_xor(r2, 2); r2 += __shfl_xor(r2, 4); r2 += __shfl_xor(r2, 8);
            if ((ci & 15) == 0) { f_r1[t] = r1; f_r2[t] = r2; } }
        v2u ucur[8];
#pragma unroll
        for (int ct = 0; ct < 8; ++ct) ucur[ct] = ureg[ct];
        if (gi + 1 < NGRP) SG_PREFETCH((gi + 1 + grot) & 15);
        __syncthreads();
        f32x4 acc[8];
#pragma unroll
        for (int ct = 0; ct < 8; ++ct) acc[ct] = (f32x4){0.f, 0.f, 0.f, 0.f};
        for (int ks = 0; ks < nks; ++ks) {
            const bf16x8 af = frag_kc(As, trow, 32 * ks + 8 * q, SG_STR);
#pragma unroll
            for (int ct = 0; ct < 8; ++ct) { const bf16x8 vf = frag_tr(Vs, 32 * ks, 16 * ct, SG_STR, lane); acc[ct] = MFMA16(vf, af, acc[ct]); }
        }
        { const float r1 = f_r1[trow], r2 = f_r2[trow], bsv = bsl[g * CH + trow]; bf16* urow = Z + (r0 + trow) * GFFN + g * 128;
#pragma unroll
          for (int ct = 0; ct < 8; ++ct) { const int c0 = 16 * ct + 4 * q; const f32x4 lg = *(const f32x4*)(lng + g * 128 + c0), lb = *(const f32x4*)(lnb + g * 128 + c0);
              const v2u uw = ucur[ct];
              const float y0 = bflo(uw.x) * (lg[0] * (acc[ct][0] - r1) + lb[0] * r2 + bsv), y1 = bfhi(uw.x) * (lg[1] * (acc[ct][1] - r1) + lb[1] * r2 + bsv);
              const float y2 = bflo(uw.y) * (lg[2] * (acc[ct][2] - r1) + lb[2] * r2 + bsv), y3 = bfhi(uw.y) * (lg[3] * (acc[ct][3] - r1) + lb[3] * r2 + bsv);
              v2u pw; pw.x = pk2(y0, y1); pw.y = pk2(y2, y3); *(v2u*)(urow + c0) = pw; } }
        __syncthreads();
    }
#undef SG_PREFETCH
}
struct Args { const float* in[18]; float* out; unsigned char* ws; int ph_lo, ph_hi; };
constexpr int NPHASE = 2 + 2 * 14;
#ifndef PG8_SP2
#define PG8_SP2 true
#endif
#ifndef PG8_ALIGN
#define PG8_ALIGN true
#endif
#if defined(PROBE_P0)
#define REP_P0(...) __VA_ARGS__ __VA_ARGS__
#else
#define REP_P0(...) __VA_ARGS__
#endif
#if defined(PROBE_PH1)
#define REP_PH1(...) __VA_ARGS__ __VA_ARGS__
#else
#define REP_PH1(...) __VA_ARGS__
#endif
#if defined(PROBE_ML)
#define REP_ML(...) __VA_ARGS__ __VA_ARGS__
#else
#define REP_ML(...) __VA_ARGS__
#endif
#if defined(PROBE_FFN1)
#define REP_FFN1(...) __VA_ARGS__ __VA_ARGS__
#else
#define REP_FFN1(...) __VA_ARGS__
#endif
#if defined(PROBE_FFN2)
#define REP_FFN2(...) __VA_ARGS__ __VA_ARGS__
#else
#define REP_FFN2(...) __VA_ARGS__
#endif
#if defined(PROBE_AIN)
#define REP_AIN(...) __VA_ARGS__ __VA_ARGS__
#else
#define REP_AIN(...) __VA_ARGS__
#endif
#if defined(PROBE_N1K)
#define REP_N1K(...) __VA_ARGS__ __VA_ARGS__
#else
#define REP_N1K(...) __VA_ARGS__
#endif
#if defined(PROBE_SGIN)
#define REP_SGIN(...) __VA_ARGS__ __VA_ARGS__
#else
#define REP_SGIN(...) __VA_ARGS__
#endif
#if defined(PROBE_SGOUT)
#define REP_SGOUT(...) __VA_ARGS__ __VA_ARGS__
#else
#define REP_SGOUT(...) __VA_ARGS__
#endif
__global__ void __launch_bounds__(NWAVES * 64, 2) trunk_fwd(Args args) {
    extern __shared__ __attribute__((aligned(16))) unsigned char lds[];
    Frame F;
    F.lds = (LAS unsigned char*)lds;
    F.MISC = (volatile LAS unsigned*)(F.lds + MISC_OFF);
    F.tid = threadIdx.x; F.lane = F.tid & 63; F.wave = __builtin_amdgcn_readfirstlane(F.tid >> 6);
    F.G = gridDim.x; { const int bx = blockIdx.x; F.vcu = (F.G % 8 == 0) ? (bx % 8) * (F.G / 8) + bx / 8 : bx; }
    unsigned char* const ws = args.ws;
    F.ctl = (gu32*)(ws + WS_CTL);
    float* const OUT = args.out;
    for (int u = F.tid; u < (LDS_BYTES - LDSCTL_OFF) / 4; u += NWAVES * 64) ((LAS unsigned*)(F.lds + LDSCTL_OFF))[u] = 0u;
    __syncthreads();
    XcdBarrier bar; bar.bar = (unsigned*)(F.ctl + CW_BAR); bar.x = 0; bar.st = nullptr;
    const bool one_launch = (args.ph_hi - args.ph_lo) > 1;
    if (one_launch) bar = xcd_barrier_post((unsigned*)(F.ctl + CW_BAR), F.MISC + 8);
    const int lo = args.ph_lo, hi = args.ph_hi;
#if defined(PROBE_BAR)
#define PROBE_BAR2 xcd_barrier(b_);
#else
#define PROBE_BAR2
#endif
#define ZDEF int z_; asm volatile("s_mov_b32 %0, 0" : "=s"(z_))
#define INP(k) ((const float*)(const GAS float*)args.in[(k) + z_])
#define WSF(off) ((float*)(ws + (size_t)(off) + z_))
#define WSB(off) ((bf16*)(ws + (size_t)(off) + z_))
#define IN(k) (lo <= (k) && (k) < hi)
#define SEAM(k) do { if (IN(k) && IN((k) + 1)) { XcdBarrier b_ = bar; asm volatile("" : "+s"(b_.bar), "+s"(b_.x)); xcd_barrier(b_); PROBE_BAR2 } } while (0)
#if defined(PROBE_NULLGEMM)
#define GEMM_NULL(Aptr, LDA, Bptr, NN, KK) do { pg8::Gemm g_{(const pg8::bf16_t*)(Aptr), (const pg8::bf16_t*)(Bptr), M, (NN), (KK), (LDA)}; pg8::StaticOrder S_; S_.init(M, (NN), F.G, (int)blockIdx.x); \
        pg8::EpiNull E_{}; pg8::gemm_phase<pg8::EpiNull, pg8::StaticOrder, PG8_ALIGN, PG8_SP2>(F.lds + RING_OFF, g_, S_, E_); } while (0)
#else
#define GEMM_NULL(Aptr, LDA, Bptr, NN, KK) do { } while (0)
#endif
#define GEMM_PHASE(EPI, Aptr, LDA, Bptr, NN, KK, ...) do { GEMM_NULL(Aptr, LDA, Bptr, NN, KK); pg8::Gemm g_{(const pg8::bf16_t*)(Aptr), (const pg8::bf16_t*)(Bptr), M, (NN), (KK), (LDA)}; pg8::StaticOrder S_; S_.init(M, (NN), F.G, (int)blockIdx.x); \
        EPI E_{__VA_ARGS__}; pg8::gemm_phase<EPI, pg8::StaticOrder, PG8_ALIGN, PG8_SP2>(F.lds + RING_OFF, g_, S_, E_); } while (0)
    constexpr size_t MODL = (size_t)NB * 6 * D;

    REP_P0(if (IN(0)) { ZDEF; In I;
        I.x = INP(0); I.c = INP(1); I.norm_g = INP(2); I.ada_w = INP(3); I.ada_b = INP(4); I.ffn_w1 = INP(5); I.ffn_w2 = INP(6); I.a_w_in = INP(7); I.a_b_if = INP(8);
        I.a_hnorm_g = INP(9); I.a_w_out = INP(10); I.b_w_in = INP(11); I.b_b_in = INP(12); I.b_ln_g = INP(13); I.b_ln_b = INP(14); I.b_ws = INP(15); I.b_bs = INP(16); I.b_w_out = INP(17);
        p0_prologue(F, I, ws + z_); })
    SEAM(0);
    REP_PH1(if (IN(1)) { ZDEF; const float* mod = WSF(WS_MOD);
        nrn_phase<false, true, true, true, false>(F, INP(0), nullptr, nullptr, WSB(WS_H), nullptr, nullptr, INP(2) + 0 * D, mod + 1 * D, mod + 0 * D, WSF(WS_GW), INP(8), WSF(WS_GATES)); })
    SEAM(1);
    { constexpr int pr = 0;
        const int pb = 2 + 14 * pr;
        const int la = 2 * pr, lb = 2 * pr + 1;
        REP_AIN(if (IN(pb + 0)) { ZDEF; GEMM_PHASE(pg8::EpiBf16<0>, WSB(WS_H), D, WSB(WS_AWIN) + (size_t)pr * AQ * D, AQ, D, (pg8::bf16_t*)WSB(WS_P), AQ); })
        SEAM(pb + 0);
        REP_ML(if (IN(pb + 1)) { ZDEF; const bf16* Pb = WSB(WS_P); const float* gates = WSF(WS_GATES); const float* hng = INP(9) + pr * D; bf16* Hb = WSB(WS_H);

#if defined(PROBE_MLCHEAP)
            for (int u = blockIdx.x; u < 2 * NB * NH; u += F.G) { const int bh = u >> 1; mlstm_unit(F, bh >> 3, bh & 7, 0, NCH, NCH, Pb, gates, hng, Hb); }
#endif
            for (int u = blockIdx.x; u < 2 * NB * NH; u += F.G) { const int bh = u >> 1, hf = u & 1; mlstm_unit(F, bh >> 3, bh & 7, 0, hf ? ML_SPLIT : 0, hf ? NCH : ML_SPLIT, Pb, gates, hng, Hb); } })
        SEAM(pb + 1);
        REP_N1K(if (IN(pb + 2)) { ZDEF; GEMM_PHASE(pg8::EpiBf16<0>, WSB(WS_H), D, WSB(WS_AWOUT) + (size_t)pr * D * D, D, D, (pg8::bf16_t*)WSB(WS_P), D); })
        SEAM(pb + 2);
        if (IN(pb + 3)) { ZDEF; const float* ma = WSF(WS_MOD) + la * MODL; const float* ng = INP(2) + la * 4 * D; if (pr == 0) nrn_phase<true, true, false, true, false>(F, INP(0), WSB(WS_X), WSB(WS_P), WSB(WS_H), ng + 1 * D, ma + 2 * D, ng + 2 * D, ma + 4 * D, ma + 3 * D, nullptr, nullptr, nullptr);
            else nrn_phase<true, true, false, false, false>(F, WSB(WS_X), WSB(WS_X), WSB(WS_P), WSB(WS_H), ng + 1 * D, ma + 2 * D, ng + 2 * D, ma + 4 * D, ma + 3 * D, nullptr, nullptr, nullptr); }
        SEAM(pb + 3);
        REP_FFN1(if (IN(pb + 4)) { ZDEF; GEMM_PHASE(pg8::EpiBf16<2>, WSB(WS_H), D, WSB(WS_W1T) + (size_t)la * D * FF, FF, D, (pg8::bf16_t*)WSB(WS_P), FF); })
        SEAM(pb + 4);
        REP_FFN2(if (IN(pb + 5)) { ZDEF; GEMM_PHASE(pg8::EpiBf16<0>, WSB(WS_P), FF, WSB(WS_W2T) + (size_t)la * D * FF, D, FF, (pg8::bf16_t*)WSB(WS_H), D); })
        SEAM(pb + 5);
        if (IN(pb + 6)) { ZDEF; const float* ma = WSF(WS_MOD) + la * MODL; const float* mb = WSF(WS_MOD) + lb * MODL; const float* ng = INP(2) + la * 4 * D;
            nrn_phase<true, true, false, false, false>(F, WSB(WS_X), WSB(WS_X), WSB(WS_H), WSB(WS_H), ng + 3 * D, ma + 5 * D, ng + 4 * D, mb + 1 * D, mb + 0 * D, nullptr, nullptr, nullptr); }
        SEAM(pb + 6);
        REP_SGIN(if (IN(pb + 7)) { ZDEF; GEMM_PHASE(pg8::EpiGeluStats, WSB(WS_H), D, WSB(WS_BWIN) + (size_t)pr * D * GFFN, GFFN, D, (pg8::bf16_t*)WSB(WS_P), GFFN, INP(12) + pr * GFFN, (pg8::f32x2*)WSF(WS_STATS)); })
        SEAM(pb + 7);
        if (IN(pb + 8)) { ZDEF; bf16* Pb = WSB(WS_P); const f32x2* stats = (const f32x2*)WSF(WS_STATS); const float* wsl = INP(15) + (size_t)pr * NGRP * CH * CH; const float* bsl = INP(16) + pr * NGRP * CH;
            const float* lng = INP(13) + pr * GHALF; const float* lnb = INP(14) + pr * GHALF;
            for (int u = F.vcu; u < NB * NCH; u += F.G) sgu_block(F, u >> 4, u & 15, Pb, stats, wsl, bsl, lng, lnb); }
        SEAM(pb + 8);
        REP_SGOUT(if (IN(pb + 9)) { ZDEF; GEMM_PHASE(pg8::EpiBf16<0>, WSB(WS_P), GFFN, WSB(WS_BWOUT) + (size_t)pr * GHALF * D, D, GHALF, (pg8::bf16_t*)WSB(WS_H), D); })
        SEAM(pb + 9);
        if (IN(pb + 10)) { ZDEF; const float* mb = WSF(WS_MOD) + lb * MODL; const float* ng = INP(2) + lb * 4 * D;
            nrn_phase<true, true, false, false, false>(F, WSB(WS_X), WSB(WS_X), WSB(WS_H), WSB(WS_H), ng + 1 * D, mb + 2 * D, ng + 2 * D, mb + 4 * D, mb + 3 * D, nullptr, nullptr, nullptr); }
        SEAM(pb + 10);
        REP_FFN1(if (IN(pb + 11)) { ZDEF; GEMM_PHASE(pg8::EpiBf16<2>, WSB(WS_H), D, WSB(WS_W1T) + (size_t)lb * D * FF, FF, D, (pg8::bf16_t*)WSB(WS_P), FF); })
        SEAM(pb + 11);
        REP_FFN2(if (IN(pb + 12)) { ZDEF; GEMM_PHASE(pg8::EpiBf16<0>, WSB(WS_P), FF, WSB(WS_W2T) + (size_t)lb * D * FF, D, FF, (pg8::bf16_t*)WSB(WS_H), D); })
        SEAM(pb + 12);
        if (IN(pb + 13)) { ZDEF; const float* mb = WSF(WS_MOD) + lb * MODL; const float* ng = INP(2) + lb * 4 * D;
            if (pr == 0) { const float* mn = mb + MODL;
                nrn_phase<true, true, true, false, false>(F, WSB(WS_X), WSB(WS_X), WSB(WS_H), WSB(WS_H), ng + 3 * D, mb + 5 * D, ng + 4 * D, mn + 1 * D, mn + 0 * D, WSF(WS_GW) + 16 * D, INP(8) + 16, WSF(WS_GATES)); }
            else nrn_phase<true, false, false, false, true>(F, WSB(WS_X), OUT, WSB(WS_H), nullptr, ng + 3 * D, mb + 5 * D, nullptr, nullptr, nullptr, nullptr, nullptr, nullptr); }
        SEAM(pb + 13);
        }
    { constexpr int pr = 1;
        const int pb = 2 + 14 * pr;
        const int la = 2 * pr, lb = 2 * pr + 1;
        REP_AIN(if (IN(pb + 0)) { ZDEF; GEMM_PHASE(pg8::EpiBf16<0>, WSB(WS_H), D, WSB(WS_AWIN) + (size_t)pr * AQ * D, AQ, D, (pg8::bf16_t*)WSB(WS_P), AQ); })
        SEAM(pb + 0);
        REP_ML(if (IN(pb + 1)) { ZDEF; const bf16* Pb = WSB(WS_P); const float* gates = WSF(WS_GATES); const float* hng = INP(9) + pr * D; bf16* Hb = WSB(WS_H);

#if defined(PROBE_MLCHEAP)
            for (int u = blockIdx.x; u < 2 * NB * NH; u += F.G) { const int bh = u >> 1; mlstm_unit(F, bh >> 3, bh & 7, 0, NCH, NCH, Pb, gates, hng, Hb); }
#endif
            for (int u = blockIdx.x; u < 2 * NB * NH; u += F.G) { const int bh = u >> 1, hf = u & 1; mlstm_unit(F, bh >> 3, bh & 7, 0, hf ? ML_SPLIT : 0, hf ? NCH : ML_SPLIT, Pb, gates, hng, Hb); } })
        SEAM(pb + 1);
        REP_N1K(if (IN(pb + 2)) { ZDEF; GEMM_PHASE(pg8::EpiBf16<0>, WSB(WS_H), D, WSB(WS_AWOUT) + (size_t)pr * D * D, D, D, (pg8::bf16_t*)WSB(WS_P), D); })
        SEAM(pb + 2);
        if (IN(pb + 3)) { ZDEF; const float* ma = WSF(WS_MOD) + la * MODL; const float* ng = INP(2) + la * 4 * D; if (pr == 0) nrn_phase<true, true, false, true, false>(F, INP(0), WSB(WS_X), WSB(WS_P), WSB(WS_H), ng + 1 * D, ma + 2 * D, ng + 2 * D, ma + 4 * D, ma + 3 * D, nullptr, nullptr, nullptr);
            else nrn_phase<true, true, false, false, false>(F, WSB(WS_X), WSB(WS_X), WSB(WS_P), WSB(WS_H), ng + 1 * D, ma + 2 * D, ng + 2 * D, ma + 4 * D, ma + 3 * D, nullptr, nullptr, nullptr); }
        SEAM(pb + 3);
        REP_FFN1(if (IN(pb + 4)) { ZDEF; GEMM_PHASE(pg8::EpiBf16<2>, WSB(WS_H), D, WSB(WS_W1T) + (size_t)la * D * FF, FF, D, (pg8::bf16_t*)WSB(WS_P), FF); })
        SEAM(pb + 4);
        REP_FFN2(if (IN(pb + 5)) { ZDEF; GEMM_PHASE(pg8::EpiBf16<0>, WSB(WS_P), FF, WSB(WS_W2T) + (size_t)la * D * FF, D, FF, (pg8::bf16_t*)WSB(WS_H), D); })
        SEAM(pb + 5);
        if (IN(pb + 6)) { ZDEF; const float* ma = WSF(WS_MOD) + la * MODL; const float* mb = WSF(WS_MOD) + lb * MODL; const float* ng = INP(2) + la * 4 * D;
            nrn_phase<true, true, false, false, false>(F, WSB(WS_X), WSB(WS_X), WSB(WS_H), WSB(WS_H), ng + 3 * D, ma + 5 * D, ng + 4 * D, mb + 1 * D, mb + 0 * D, nullptr, nullptr, nullptr); }
        SEAM(pb + 6);
        REP_SGIN(if (IN(pb + 7)) { ZDEF; GEMM_PHASE(pg8::EpiGeluStats, WSB(WS_H), D, WSB(WS_BWIN) + (size_t)pr * D * GFFN, GFFN, D, (pg8::bf16_t*)WSB(WS_P), GFFN, INP(12) + pr * GFFN, (pg8::f32x2*)WSF(WS_STATS)); })
        SEAM(pb + 7);
        if (IN(pb + 8)) { ZDEF; bf16* Pb = WSB(WS_P); const f32x2* stats = (const f32x2*)WSF(WS_STATS); const float* wsl = INP(15) + (size_t)pr * NGRP * CH * CH; const float* bsl = INP(16) + pr * NGRP * CH;
            const float* lng = INP(13) + pr * GHALF; const float* lnb = INP(14) + pr * GHALF;
            for (int u = F.vcu; u < NB * NCH; u += F.G) sgu_block(F, u >> 4, u & 15, Pb, stats, wsl, bsl, lng, lnb); }
        SEAM(pb + 8);
        REP_SGOUT(if (IN(pb + 9)) { ZDEF; GEMM_PHASE(pg8::EpiBf16<0>, WSB(WS_P), GFFN, WSB(WS_BWOUT) + (size_t)pr * GHALF * D, D, GHALF, (pg8::bf16_t*)WSB(WS_H), D); })
        SEAM(pb + 9);
        if (IN(pb + 10)) { ZDEF; const float* mb = WSF(WS_MOD) + lb * MODL; const float* ng = INP(2) + lb * 4 * D;
            nrn_phase<true, true, false, false, false>(F, WSB(WS_X), WSB(WS_X), WSB(WS_H), WSB(WS_H), ng + 1 * D, mb + 2 * D, ng + 2 * D, mb + 4 * D, mb + 3 * D, nullptr, nullptr, nullptr); }
        SEAM(pb + 10);
        REP_FFN1(if (IN(pb + 11)) { ZDEF; GEMM_PHASE(pg8::EpiBf16<2>, WSB(WS_H), D, WSB(WS_W1T) + (size_t)lb * D * FF, FF, D, (pg8::bf16_t*)WSB(WS_P), FF); })
        SEAM(pb + 11);
        REP_FFN2(if (IN(pb + 12)) { ZDEF; GEMM_PHASE(pg8::EpiBf16<0>, WSB(WS_P), FF, WSB(WS_W2T) + (size_t)lb * D * FF, D, FF, (pg8::bf16_t*)WSB(WS_H), D); })
        SEAM(pb + 12);
        if (IN(pb + 13)) { ZDEF; const float* mb = WSF(WS_MOD) + lb * MODL; const float* ng = INP(2) + lb * 4 * D;
            if (pr == 0) { const float* mn = mb + MODL;
                nrn_phase<true, true, true, false, false>(F, WSB(WS_X), WSB(WS_X), WSB(WS_H), WSB(WS_H), ng + 3 * D, mb + 5 * D, ng + 4 * D, mn + 1 * D, mn + 0 * D, WSF(WS_GW) + 16 * D, INP(8) + 16, WSF(WS_GATES)); }
            else nrn_phase<true, false, false, false, true>(F, WSB(WS_X), OUT, WSB(WS_H), nullptr, ng + 3 * D, mb + 5 * D, nullptr, nullptr, nullptr, nullptr, nullptr, nullptr); }
        SEAM(pb + 13);
        }
#undef ZDEF
#undef INP
#undef WSF
#undef WSB
#undef IN
#undef SEAM
#undef GEMM_PHASE
}

extern "C" void kernel_launch(void* const* d_in, const int* in_sizes, int n_in, void* d_out, int out_size, void* d_ws, size_t ws_size, hipStream_t stream) {
    static int grid = 0;
    if (grid == 0) {
        if (n_in != 18 || in_sizes[0] != M * D || out_size != M * D || ws_size < WS_END) { fprintf(stderr, "kernel_launch: unexpected shapes (n_in %d, in0 %d, out %d, ws %zu); nothing launched\n", n_in, n_in > 0 ? in_sizes[0] : -1, out_size, ws_size); grid = -1; return; }
        int dev = 0, cus = 0, per_cu = 0;
        if (hipGetDevice(&dev) != hipSuccess || hipDeviceGetAttribute(&cus, hipDeviceAttributeMultiprocessorCount, dev) != hipSuccess) { grid = -1; return; }
        if (hipFuncSetAttribute((const void*)trunk_fwd, hipFuncAttributeMaxDynamicSharedMemorySize, LDS_BYTES) != hipSuccess) { fprintf(stderr, "kernel_launch: hipFuncSetAttribute failed\n"); grid = -1; return; }
        if (hipOccupancyMaxActiveBlocksPerMultiprocessor(&per_cu, (const void*)trunk_fwd, NWAVES * 64, LDS_BYTES) != hipSuccess || per_cu < 1) fprintf(stderr, "kernel_launch: occupancy query reports %d\n", per_cu);
        (void)hipGetLastError();
        grid = cus;
    }
    if (grid < 0) return;
    if (hipMemsetAsync((char*)d_ws + WS_CTL, 0, CTL_ZERO_BYTES, stream) != hipSuccess) return;
    Args a{};
    for (int i = 0; i < 18; ++i) a.in[i] = (const float*)d_in[i];
    a.out = (float*)d_out; a.ws = (unsigned char*)d_ws;
#if MK_N_LAUNCHES == 1
    a.ph_lo = 0; a.ph_hi = NPHASE;
    hipLaunchKernelGGL(trunk_fwd, dim3(grid), dim3(NWAVES * 64), LDS_BYTES, stream, a);
#else
    for (int p = 0; p < NPHASE; ++p) { a.ph_lo = p; a.ph_hi = p + 1; hipLaunchKernelGGL(trunk_fwd, dim3(grid), dim3(NWAVES * 64), LDS_BYTES, stream, a); }
#endif
}
```
